# Optimizing an MI355X kernel written in HIP

```python
import jax, jax.numpy as jnp
from jax import lax
import numpy as np

D_MODEL = 2048
BATCH = 1
SEQ = 16384
DEPTH = 1

N_HEADS = 8
N_KV_HEADS = 2
HEAD_DIM = 128
ATTN_WIDTH = N_HEADS * HEAD_DIM
KV_WIDTH = N_KV_HEADS * HEAD_DIM
Q_BLOCK = 128
ROPE_THETA = 10000.0
ROPE_PAIRS = HEAD_DIM // 4
GRID_W = 64
LRU_WIDTH = D_MODEL // 2
LRU_BLOCKS = 8
LRU_BW = LRU_WIDTH // LRU_BLOCKS
LRU_C = 8.0
CONV_W = 4
CONV_PAD = (2, 1)
MIX_WIDTH = ATTN_WIDTH + LRU_WIDTH
IN_WIDTH = ATTN_WIDTH + 2 * KV_WIDTH + ATTN_WIDTH + 2 * LRU_WIDTH
SPLITS = (ATTN_WIDTH,
          ATTN_WIDTH + KV_WIDTH,
          ATTN_WIDTH + 2 * KV_WIDTH,
          2 * ATTN_WIDTH + 2 * KV_WIDTH,
          2 * ATTN_WIDTH + 2 * KV_WIDTH + LRU_WIDTH)
EPS = 1e-6

kernel_name = "hymba_griffin_axialrope_hybrid_block"


def rms_norm(x, w):
    xf = x.astype(jnp.float32)
    y = xf * lax.rsqrt(jnp.mean(xf * xf, axis=-1, keepdims=True) + EPS)
    return (y * w.astype(jnp.float32)).astype(x.dtype)


def axial_rope_tables(seq_len):
    rows = seq_len // GRID_W
    row = jnp.repeat(jnp.arange(rows, dtype=jnp.float32), GRID_W)
    col = jnp.tile(jnp.arange(GRID_W, dtype=jnp.float32), rows)
    inv_freq = ROPE_THETA ** (-jnp.arange(ROPE_PAIRS, dtype=jnp.float32) / ROPE_PAIRS)
    ang_r = row[:, None] * inv_freq[None, :]
    ang_c = col[:, None] * inv_freq[None, :]
    return jnp.cos(ang_r), jnp.sin(ang_r), jnp.cos(ang_c), jnp.sin(ang_c)


def rope_half(x, cos, sin):
    c = cos[None, :, None, :]
    s = sin[None, :, None, :]
    x1, x2 = jnp.split(x, 2, axis=-1)
    return jnp.concatenate([x1 * c - x2 * s, x2 * c + x1 * s], axis=-1)


def apply_axial_rope(x, tables):
    cr, sr, cc, sc = tables
    xf = x.astype(jnp.float32)
    x_row, x_col = jnp.split(xf, 2, axis=-1)
    out = jnp.concatenate([rope_half(x_row, cr, sr), rope_half(x_col, cc, sc)], axis=-1)
    return out.astype(x.dtype)


def attention_group(q, k, v, q_norm_w, k_norm_w):
    B, S, _ = q.shape
    G = N_HEADS // N_KV_HEADS
    tables = axial_rope_tables(S)
    q = rms_norm(q.reshape(B, S, N_HEADS, HEAD_DIM), q_norm_w)
    k = rms_norm(k.reshape(B, S, N_KV_HEADS, HEAD_DIM), k_norm_w)
    q = apply_axial_rope(q, tables)
    k = apply_axial_rope(k, tables)
    v = v.reshape(B, S, N_KV_HEADS, HEAD_DIM)
    scale = HEAD_DIM ** -0.5
    nb = S // Q_BLOCK
    q_blocks = q.reshape(B, nb, Q_BLOCK, N_KV_HEADS, G, HEAD_DIM).transpose(1, 0, 3, 4, 2, 5)
    k_t = k.transpose(0, 2, 1, 3)
    v_t = v.transpose(0, 2, 1, 3)

    def block(qb):
        s = jnp.einsum('bkgqd,bksd->bkgqs', qb.astype(jnp.float32), k_t.astype(jnp.float32)) * scale
        p = jax.nn.softmax(s, axis=-1)
        return jnp.einsum('bkgqs,bksd->bkgqd', p, v_t.astype(jnp.float32)).astype(q.dtype)

    out = lax.map(block, q_blocks)
    return out.transpose(1, 0, 4, 2, 3, 5).reshape(B, S, ATTN_WIDTH)


def block_diag(x, w):
    B, S, _ = x.shape
    xb = x.reshape(B, S, LRU_BLOCKS, LRU_BW)
    return jnp.einsum('bsnc,ncd->bsnd', xb, w).reshape(B, S, LRU_WIDTH)


def linear_scan(a, b, reverse):
    def op(c1, c2):
        a1, b1 = c1
        a2, b2 = c2
        return a1 * a2, a2 * b1 + b2
    _, h = lax.associative_scan(op, (a, b), axis=1, reverse=reverse)
    return h


def rg_lru_direction(xf, wa, ba, wx, bx, lam, reverse):
    r = jax.nn.sigmoid(block_diag(xf, wa) + ba)
    i = jax.nn.sigmoid(block_diag(xf, wx) + bx)
    log_a = -LRU_C * r * jax.nn.softplus(-lam)
    a = jnp.exp(log_a)
    mult = jnp.sqrt(-jnp.expm1(2.0 * log_a))
    return linear_scan(a, mult * (i * xf), reverse)


def lru_group(xr, conv_w, conv_b, lru_wa, lru_ba, lru_wx, lru_bx, lru_lambda):
    xc = lax.conv_general_dilated(xr, conv_w.astype(xr.dtype), window_strides=(1,),
                                  padding=[CONV_PAD],
                                  dimension_numbers=('NWC', 'WIO', 'NWC'),
                                  feature_group_count=LRU_WIDTH) + conv_b
    xf = xc.astype(jnp.float32)
    h_fwd = rg_lru_direction(xf, lru_wa[0].astype(jnp.float32), lru_ba[0].astype(jnp.float32),
                             lru_wx[0].astype(jnp.float32), lru_bx[0].astype(jnp.float32),
                             lru_lambda[0].astype(jnp.float32), reverse=False)
    h_bwd = rg_lru_direction(xf, lru_wa[1].astype(jnp.float32), lru_ba[1].astype(jnp.float32),
                             lru_wx[1].astype(jnp.float32), lru_bx[1].astype(jnp.float32),
                             lru_lambda[1].astype(jnp.float32), reverse=True)
    return (h_fwd + h_bwd).astype(xr.dtype)


def setup_inputs(seed: int = 0) -> dict:
    key = jax.random.key(seed)
    ks = jax.random.split(key, 16)
    f32 = jnp.float32
    x = jax.random.normal(ks[0], (BATCH, SEQ, D_MODEL), f32)
    norm_w = 1.0 + 0.02 * jax.random.normal(ks[1], (D_MODEL,), f32)
    w_in = jax.random.normal(ks[2], (D_MODEL, IN_WIDTH), f32) * D_MODEL ** -0.5
    q_norm_w = 1.0 + 0.02 * jax.random.normal(ks[3], (HEAD_DIM,), f32)
    k_norm_w = 1.0 + 0.02 * jax.random.normal(ks[4], (HEAD_DIM,), f32)
    conv_w = jax.random.normal(ks[5], (CONV_W, 1, LRU_WIDTH), f32) * CONV_W ** -0.5
    conv_b = 0.01 * jax.random.normal(ks[6], (LRU_WIDTH,), f32)
    lru_wa = jax.random.normal(ks[7], (2, LRU_BLOCKS, LRU_BW, LRU_BW), f32) * LRU_BW ** -0.5
    lru_ba = 0.01 * jax.random.normal(ks[8], (2, LRU_WIDTH), f32)
    lru_wx = jax.random.normal(ks[9], (2, LRU_BLOCKS, LRU_BW, LRU_BW), f32) * LRU_BW ** -0.5
    lru_bx = 0.01 * jax.random.normal(ks[10], (2, LRU_WIDTH), f32)
    u = jax.random.uniform(ks[11], (2, LRU_WIDTH), f32, minval=0.9, maxval=0.999)
    a0 = u ** (1.0 / LRU_C)
    lru_lambda = jnp.log(a0) - jnp.log1p(-a0)
    attn_norm_w = 1.0 + 0.02 * jax.random.normal(ks[12], (ATTN_WIDTH,), f32)
    lru_norm_w = 1.0 + 0.02 * jax.random.normal(ks[13], (LRU_WIDTH,), f32)
    w_out = jax.random.normal(ks[14], (MIX_WIDTH, D_MODEL), f32) * MIX_WIDTH ** -0.5
    return {"x": x, "norm_w": norm_w, "w_in": w_in, "q_norm_w": q_norm_w, "k_norm_w": k_norm_w,
            "conv_w": conv_w, "conv_b": conv_b, "lru_wa": lru_wa, "lru_ba": lru_ba,
            "lru_wx": lru_wx, "lru_bx": lru_bx, "lru_lambda": lru_lambda,
            "attn_norm_w": attn_norm_w, "lru_norm_w": lru_norm_w, "w_out": w_out}


def hybrid_layer(x, norm_w, w_in, q_norm_w, k_norm_w, conv_w, conv_b, lru_wa, lru_ba, lru_wx,
                 lru_bx, lru_lambda, attn_norm_w, lru_norm_w, w_out):
    h = rms_norm(x, norm_w)
    proj = jnp.einsum('bsd,de->bse', h, w_in)
    q, k, v, g_attn, xr, g_lru = jnp.split(proj, SPLITS, axis=-1)
    attn_out = attention_group(q, k, v, q_norm_w, k_norm_w)
    lru_out = lru_group(xr, conv_w, conv_b, lru_wa, lru_ba, lru_wx, lru_bx, lru_lambda)
    mixed = jnp.concatenate([rms_norm(attn_out, attn_norm_w) * jax.nn.silu(g_attn),
                             rms_norm(lru_out, lru_norm_w) * jax.nn.silu(g_lru)], axis=-1)
    return x + jnp.einsum('bse,ed->bsd', mixed, w_out)


def reference(x, norm_w, w_in, q_norm_w, k_norm_w, conv_w, conv_b, lru_wa, lru_ba, lru_wx,
              lru_bx, lru_lambda, attn_norm_w, lru_norm_w, w_out):
    for _ in range(DEPTH):
        x = hybrid_layer(x, norm_w, w_in, q_norm_w, k_norm_w, conv_w, conv_b, lru_wa, lru_ba,
                         lru_wx, lru_bx, lru_lambda, attn_norm_w, lru_norm_w, w_out)
    return x
```

```cpp
#include <hip/hip_runtime.h>
#include <hip/hip_bf16.h>
#include <hip/hip_cooperative_groups.h>
#include <cstdio>
#include <cstdint>
namespace cg = cooperative_groups;
namespace pg8 {
#define PG8_LAS __attribute__((address_space(3)))
typedef unsigned short bf16_t;
typedef short bf16x8 __attribute__((ext_vector_type(8)));
typedef float f32x4 __attribute__((ext_vector_type(4)));
typedef unsigned u32x4 __attribute__((ext_vector_type(4)));
constexpr int BM = 256, BK = 64, HALF = 128, HTB = HALF * BK * 2  , STAGE_BYTES = 8 * HTB, NXCD = 8, WGM = 8;

__host__ __device__ __forceinline__ int lds_byte(int r, int c) { const int st = (r >> 4) * 2 + (c >> 5), rr = r & 15, cc = c & 31, ob = rr * 64 + cc * 2; return st * 1024 + (ob ^ (((ob >> 9) & 1) << 5)); }
__host__ __device__ __forceinline__ void stage_rc(int b, int& R, int& C) { const int st = b / 1024, sb = b % 1024, swz = sb ^ (((sb >> 9) & 1) << 5); R = (st >> 1) * 16 + swz / 64; C = (st & 1) * 32 + (swz % 64) / 2; }
__host__ __device__ __forceinline__ int perm32(int rho) { const int n = rho >> 4, i = rho & 15; return 8 * (i >> 2) + 4 * n + (i & 3); }

struct Unit { int pm, pn; };
struct Gemm { const bf16_t* A; const bf16_t* Bt; int M, N, K; };

struct StaticOrder {
    int nM, nN, nwg, G, c, lbeg, lend;
    __host__ __device__ void init(int M, int N, int G_, int c_) { nM = M / BM; nN = N / BM; nwg = nM * nN; G = G_; c = c_; lbeg = 0; lend = nwg; }
    __host__ __device__ void map(long L, Unit& u) const {
        int wgid = (int)L; { const int q = nwg / NXCD, r = nwg % NXCD, xcd = wgid % NXCD, off = wgid / NXCD; wgid = (xcd < r ? xcd * (q + 1) : r * (q + 1) + (xcd - r) * q) + off; }
        const int nig = WGM * nN, gid = wgid / nig, fm = gid * WGM, gsz = (nM - fm) < WGM ? (nM - fm) : WGM;
        u.pm = fm + ((wgid % nig) % gsz); u.pn = (wgid % nig) / gsz; }
    __host__ __device__ bool next(int i, Unit& u) const {
        const long L = (long)lbeg + (long)i * G + c; if (L >= lend) return false;
        map(L, u); return true;
    }
    __device__ __forceinline__ void a_ready(const Unit&) const {}
    __device__ __forceinline__ void done(const Unit&) const {}
};

__device__ __forceinline__ unsigned cvt_pk_bf16(float lo, float hi) { unsigned r; asm volatile("v_cvt_pk_bf16_f32 %0, %1, %2" : "=v"(r) : "v"(lo), "v"(hi)); return r; }
__device__ __forceinline__ void store16_wt(void* p, u32x4 v) { asm volatile("global_store_dwordx4 %0, %1, off sc1" :: "v"(p), "v"(v) : "memory"); }
struct EpiStoreBf16 {
    static constexpr bool PERM = true, AFTER_DRAIN = false;
    bf16_t* O; int ldc;
    __device__ __forceinline__ void operator()(const f32x4 (&acc)[2][2][4][2], const Unit& u, int wr, int wc, int fr, int fq) const {
        const int row0 = u.pm * BM + wr * 64 + fr; const int col0 = u.pn * BM + wc * 32 + 8 * fq;
#pragma unroll
        for (int ai = 0; ai < 2; ++ai)
#pragma unroll
            for (int m = 0; m < 4; ++m) { bf16_t* rowp = O + (size_t)(row0 + ai * HALF + m * 16) * ldc + col0;
#pragma unroll
                for (int bj = 0; bj < 2; ++bj) { const f32x4 v0 = acc[ai][bj][m][0], v1 = acc[ai][bj][m][1];
                    u32x4 w; w.x = cvt_pk_bf16(v0[0], v0[1]); w.y = cvt_pk_bf16(v0[2], v0[3]); w.z = cvt_pk_bf16(v1[0], v1[1]); w.w = cvt_pk_bf16(v1[2], v1[3]);
                    store16_wt(rowp + bj * HALF, w); } }
    }
};
struct EpiStoreBf16Half {
    static constexpr bool PERM = true, AFTER_DRAIN = false;
    bf16_t* O; int ldc; int half;
    __device__ __forceinline__ void operator()(const f32x4 (&acc)[2][2][4][2], const Unit& u, int wr, int wc, int fr, int fq) const {
        const int row0 = u.pm * BM + wr * 64 + fr; const int col0 = u.pn * BM + half * HALF + wc * 32 + 8 * fq;
#pragma unroll
        for (int ai = 0; ai < 2; ++ai)
#pragma unroll
            for (int m = 0; m < 4; ++m) { bf16_t* rowp = O + (size_t)(row0 + ai * HALF + m * 16) * ldc + col0;
                const f32x4 v0 = acc[ai][0][m][0], v1 = acc[ai][0][m][1];
                u32x4 w; w.x = cvt_pk_bf16(v0[0], v0[1]); w.y = cvt_pk_bf16(v0[2], v0[3]); w.z = cvt_pk_bf16(v1[0], v1[1]); w.w = cvt_pk_bf16(v1[2], v1[3]);
                store16_wt(rowp, w); }
    }
};
struct EpiResidual {
    static constexpr bool PERM = false, AFTER_DRAIN = false;
    const float* x; float* out; int ldc;
    __device__ __forceinline__ void operator()(const f32x4 (&acc)[2][2][4][2], const Unit& u, int wr, int wc, int fr, int fq) const {
        const int row0 = u.pm * BM + wr * 64 + fr; const int col0 = u.pn * BM + wc * 32 + 4 * fq;
#pragma unroll
        for (int ai = 0; ai < 2; ++ai)
#pragma unroll
            for (int m = 0; m < 4; ++m) { const size_t off = (size_t)(row0 + ai * HALF + m * 16) * ldc + col0;
#pragma unroll
                for (int bj = 0; bj < 2; ++bj)
#pragma unroll
                    for (int n = 0; n < 2; ++n) { const f32x4 xv = *(const f32x4*)(x + off + bj * HALF + n * 16); *(f32x4*)(out + off + bj * HALF + n * 16) = xv + acc[ai][bj][m][n]; } }
    }
};
template <class Epi, class Sched, bool ALIGN_EPI = false, bool SP2 = false, int NBJ = 2>
__device__ __forceinline__ void gemm_phase(PG8_LAS unsigned char* lds, const Gemm g, const Sched& S, const Epi& E, const size_t bbase = 0) {
    const int tid = threadIdx.x, wid = __builtin_amdgcn_readfirstlane(tid >> 6), lane = tid & 63, wr = wid >> 2, wc = wid & 3, fr = lane & 15, fq = lane >> 4;
    const int K = g.K, nt = K / BK;
    unsigned voffA[2], voffB[2];
#pragma unroll
    for (int i = 0; i < 2; ++i) { int R, C; stage_rc(tid * 16 + i * 8192, R, C); const int Rb = Epi::PERM ? ((R & ~31) + perm32(R & 31)) : R;
        voffA[i] = (unsigned)(R * K + C) * 2u; voffB[i] = (unsigned)(Rb * K + C) * 2u; }
    const size_t kstep = (size_t)(BK * 2);
    const size_t hstep = (size_t)HALF * K * 2;
    const size_t tstep = 2 * hstep;
    const unsigned ldsw = (unsigned)wid * 1024u;
    const int aoff = lds_byte(wr * 64 + fr, fq * 8), boff = lds_byte(wc * 32 + fr, fq * 8);
#define PG8_SA(b, h) (((b) * 2 + (h)) * HTB)
#define PG8_SB(b, h) ((4 + (b) * 2 + (h)) * HTB)
#define PG8_STAGE(bufoff, gbase, voff) do { _Pragma("unroll") for (int _i = 0; _i < 2; ++_i) \
        __builtin_amdgcn_global_load_lds((const unsigned*)((const char*)(gbase) + (voff)[_i]), (PG8_LAS unsigned*)(lds + (bufoff) + ldsw + _i * 8192), 16, 0, 0); } while (0)
#define PG8_LDA(dst, b, h) do { _Pragma("unroll") for (int m = 0; m < 4; ++m) _Pragma("unroll") for (int k = 0; k < 2; ++k) dst[m][k] = *(const PG8_LAS bf16x8*)(lds + PG8_SA(b, h) + aoff + m * 2048 + k * 1024); } while (0)
#define PG8_LDB(dst, b, h) do { _Pragma("unroll") for (int n = 0; n < 2; ++n) _Pragma("unroll") for (int k = 0; k < 2; ++k) dst[n][k] = *(const PG8_LAS bf16x8*)(lds + PG8_SB(b, h) + boff + n * 2048 + k * 1024); } while (0)
#define PG8_MMA(ai, bj, At, Bt) do { __builtin_amdgcn_s_setprio(1); _Pragma("unroll") for (int m = 0; m < 4; ++m) _Pragma("unroll") for (int n = 0; n < 2; ++n) _Pragma("unroll") for (int k = 0; k < 2; ++k) \
        acc[ai][bj][m][n] = __builtin_amdgcn_mfma_f32_16x16x32_bf16(Bt[n][k], At[m][k], acc[ai][bj][m][n], 0, 0, 0); __builtin_amdgcn_s_setprio(0); } while (0)
#define PG8_WAIT_V(n) asm volatile("s_waitcnt vmcnt(" #n ")" ::: "memory")
#define PG8_WAIT_L(n) asm volatile("s_waitcnt lgkmcnt(" #n ")" ::: "memory")
#define PG8_BAR __builtin_amdgcn_s_barrier()
#define PG8_SCHED __builtin_amdgcn_sched_barrier(0)
    Unit cur, nxt; int ui = 0;
    if (!S.next(0, cur)) return;
    f32x4 acc[2][2][4][2];
#pragma unroll
    for (int a = 0; a < 2; ++a)
#pragma unroll
        for (int b = 0; b < 2; ++b)
#pragma unroll
            for (int m = 0; m < 4; ++m)
#pragma unroll
                for (int n = 0; n < 2; ++n) acc[a][b][m][n] = (f32x4){0.f, 0.f, 0.f, 0.f};
    bf16x8 At[4][2], B0[2][2], B1[2][2];
    const char* cA = (const char*)g.A + (size_t)cur.pm * tstep; const char* cB = (const char*)g.Bt + (size_t)cur.pn * tstep + bbase;
    S.a_ready(cur);
    if constexpr (SP2) {
        PG8_STAGE(PG8_SB(0, 0), cB, voffB); PG8_STAGE(PG8_SB(0, 1), cB + hstep, voffB); PG8_STAGE(PG8_SA(0, 0), cA, voffA); PG8_STAGE(PG8_SA(0, 1), cA + hstep, voffA);
        if (wr == 1) PG8_BAR;
        PG8_WAIT_V(2); PG8_BAR;
        PG8_STAGE(PG8_SB(1, 0), cB + kstep, voffB); PG8_STAGE(PG8_SA(1, 0), cA + kstep, voffA); PG8_STAGE(PG8_SB(1, 1), cB + hstep + kstep, voffB);
        PG8_WAIT_V(6); PG8_BAR;
    } else {
        PG8_STAGE(PG8_SB(0, 0), cB, voffB); PG8_STAGE(PG8_SA(0, 0), cA, voffA); PG8_STAGE(PG8_SB(0, 1), cB + hstep, voffB); PG8_STAGE(PG8_SA(0, 1), cA + hstep, voffA);
        if (wr == 1) PG8_BAR;
        PG8_WAIT_V(4); PG8_BAR;
        PG8_STAGE(PG8_SB(1, 0), cB + kstep, voffB); PG8_STAGE(PG8_SA(1, 0), cA + kstep, voffA); PG8_STAGE(PG8_SB(1, 1), cB + hstep + kstep, voffB);
        PG8_WAIT_V(6); PG8_BAR;
    }
    for (;;) {
        const bool has_next = S.next(ui + 1, nxt);
        const char* nA = has_next ? (const char*)g.A + (size_t)nxt.pm * tstep : cA; const char* nB = has_next ? (const char*)g.Bt + (size_t)nxt.pn * tstep + bbase : cB;
        for (int t = 0; t < nt; t += 2) {
            const bool last = (t == nt - 2);
            const char* a1 = cA + (size_t)(t + 1) * kstep;
            const char* a2 = last ? nA : cA + (size_t)(t + 2) * kstep; const char* b2 = last ? nB : cB + (size_t)(t + 2) * kstep;
            const char* a3 = a2 + kstep; const char* b3 = b2 + kstep;
            if (last && has_next) S.a_ready(nxt);
            if constexpr (SP2) {
            PG8_LDB(B0, 0, 0); PG8_LDB(B1, 0, 1); PG8_SCHED; PG8_LDA(At, 0, 0); PG8_STAGE(PG8_SA(1, 1), a1 + hstep, voffA);
            PG8_WAIT_V(8); PG8_WAIT_L(0); PG8_BAR; PG8_MMA(0, 0, At, B0); { if (NBJ == 2) PG8_MMA(0, 1, At, B1); } PG8_BAR; PG8_SCHED;
            PG8_LDA(At, 0, 1); PG8_STAGE(PG8_SB(0, 0), b2, voffB); PG8_STAGE(PG8_SB(0, 1), b2 + hstep, voffB); PG8_STAGE(PG8_SA(0, 0), a2, voffA);
            PG8_WAIT_V(8); PG8_WAIT_L(0); PG8_BAR; PG8_MMA(1, 0, At, B0); { if (NBJ == 2) PG8_MMA(1, 1, At, B1); } PG8_BAR; PG8_SCHED;
            PG8_LDB(B0, 1, 0); PG8_LDB(B1, 1, 1); PG8_SCHED; PG8_LDA(At, 1, 0); PG8_STAGE(PG8_SA(0, 1), a2 + hstep, voffA);
            PG8_WAIT_V(8); PG8_WAIT_L(0); PG8_BAR; PG8_MMA(0, 0, At, B0); { if (NBJ == 2) PG8_MMA(0, 1, At, B1); } PG8_BAR; PG8_SCHED;
            PG8_LDA(At, 1, 1); PG8_STAGE(PG8_SB(1, 0), b3, voffB); PG8_STAGE(PG8_SB(1, 1), b3 + hstep, voffB); PG8_STAGE(PG8_SA(1, 0), a3, voffA);
            PG8_WAIT_V(8); PG8_WAIT_L(0); PG8_BAR; PG8_MMA(1, 0, At, B0); { if (NBJ == 2) PG8_MMA(1, 1, At, B1); } PG8_BAR; PG8_SCHED;
            } else {
            PG8_LDB(B0, 0, 0); PG8_SCHED; PG8_LDA(At, 0, 0); PG8_STAGE(PG8_SA(1, 1), a1 + hstep, voffA);
            PG8_WAIT_L(8); PG8_BAR; PG8_WAIT_L(0); PG8_MMA(0, 0, At, B0); PG8_BAR; PG8_SCHED;
            PG8_LDB(B1, 0, 1); PG8_STAGE(PG8_SB(0, 0), b2, voffB);
            PG8_BAR; PG8_WAIT_L(0); { if (NBJ == 2) PG8_MMA(0, 1, At, B1); } PG8_BAR;
            PG8_LDA(At, 0, 1); PG8_STAGE(PG8_SA(0, 0), a2, voffA);
            PG8_BAR; PG8_WAIT_L(0); PG8_MMA(1, 0, At, B0); PG8_BAR; PG8_SCHED;
            PG8_STAGE(PG8_SB(0, 1), b2 + hstep, voffB);
            PG8_WAIT_V(6); PG8_BAR; { if (NBJ == 2) PG8_MMA(1, 1, At, B1); } PG8_BAR;
            PG8_LDB(B0, 1, 0); PG8_SCHED; PG8_LDA(At, 1, 0); PG8_STAGE(PG8_SA(0, 1), a2 + hstep, voffA);
            PG8_WAIT_L(8); PG8_BAR; PG8_WAIT_L(0); PG8_MMA(0, 0, At, B0); PG8_BAR; PG8_SCHED;
            PG8_LDB(B1, 1, 1); PG8_STAGE(PG8_SB(1, 0), b3, voffB);
            PG8_BAR; PG8_WAIT_L(0); { if (NBJ == 2) PG8_MMA(0, 1, At, B1); } PG8_BAR;
            PG8_LDA(At, 1, 1); PG8_STAGE(PG8_SA(1, 0), a3, voffA);
            PG8_BAR; PG8_WAIT_L(0); PG8_MMA(1, 0, At, B0); PG8_BAR; PG8_SCHED;
            PG8_STAGE(PG8_SB(1, 1), b3 + hstep, voffB);
            PG8_WAIT_V(6); PG8_BAR; { if (NBJ == 2) PG8_MMA(1, 1, At, B1); } PG8_BAR;
            }
        }
        if constexpr (ALIGN_EPI) { if (wr == 0) PG8_BAR; }
        if constexpr (!Epi::AFTER_DRAIN) { E(acc, cur, wr, wc, fr, fq); S.done(cur); }
        if (!has_next) break;
#pragma unroll
        for (int a = 0; a < 2; ++a)
#pragma unroll
            for (int b = 0; b < 2; ++b)
#pragma unroll
                for (int m = 0; m < 4; ++m)
#pragma unroll
                    for (int n = 0; n < 2; ++n) acc[a][b][m][n] = (f32x4){0.f, 0.f, 0.f, 0.f};
        cur = nxt; cA = nA; cB = nB; ++ui;
        if constexpr (ALIGN_EPI) { if (wr == 1) PG8_BAR; }
    }
    PG8_WAIT_V(0);
    if constexpr (!ALIGN_EPI) { if (wr == 0) PG8_BAR; }
    PG8_BAR;
    if constexpr (Epi::AFTER_DRAIN) { E.fused(acc, cur, wr, wc, fr, fq, lds, wid, lane); S.done(cur); }
#undef PG8_SA
#undef PG8_SB
#undef PG8_STAGE
#undef PG8_LDA
#undef PG8_LDB
#undef PG8_MMA
#undef PG8_WAIT_V
#undef PG8_WAIT_L
#undef PG8_BAR
#undef PG8_SCHED
}
}
namespace att {
using bf16 = __hip_bfloat16;
constexpr int   D = 128, NW = 8, QBLK = 32, KVBLK = 64;
constexpr float SCALE = 0.088388347648318440f;
constexpr float THR2 = 11.f;
constexpr float QSCALE = SCALE * 1.4426950408889634f;
constexpr int SDEPTH = 1;
constexpr int LDQ = 4608, LDK = 4608, LDO = 1024;
constexpr size_t SHM_V = KVBLK * D * 2, SHM_K = KVBLK * D * 2, SHM_ATTN = 2 * SHM_V + 2 * SHM_K + NW * 64 * 4;
using bf16x8 = __attribute__((ext_vector_type(8))) short;
using s16x4  = __attribute__((ext_vector_type(4))) short;
using f32x16 = __attribute__((ext_vector_type(16))) float;
using f32x8  = __attribute__((ext_vector_type(8))) float;
using u32x4  = __attribute__((ext_vector_type(4))) unsigned;
#define KSWZ(row, colB) ((row) * 256 + ((colB) ^ (((row) & 7) << 4)))
#define SBAR() __builtin_amdgcn_sched_barrier(0)
__device__ __forceinline__ int crow(int r, int hi) { return (r & 3) + 8 * (r >> 2) + 4 * hi; }
__device__ __forceinline__ unsigned cvtpk(float lo, float hi) {
  unsigned r; asm volatile("v_cvt_pk_bf16_f32 %0, %1, %2" : "=v"(r) : "v"(lo), "v"(hi)); return r;
}
template <typename TIn> struct Stage;
template <> struct Stage<bf16>  { using T = bf16x8;
  __device__ static __forceinline__ T ld8(const bf16* p) { return *reinterpret_cast<const bf16x8*>(p); }
  __device__ static __forceinline__ bf16x8 tobf(T x) { return x; } };
template <> struct Stage<float> { using T = f32x8;
  __device__ static __forceinline__ T ld8(const float* p) { return *reinterpret_cast<const f32x8*>(p); }
  __device__ static __forceinline__ bf16x8 tobf(T x) {
    u32x4 w = {cvtpk(x[0], x[1]), cvtpk(x[2], x[3]), cvtpk(x[4], x[5]), cvtpk(x[6], x[7])}; return *reinterpret_cast<bf16x8*>(&w); } };

template <bool FIRST>
__device__ __forceinline__ void partialSM(f32x16& p0, f32x16& p1, f32x16& negm, float& alpha) {
  float pa_ = fmaxf(fmaxf(p0[0], p0[1]), p1[0]), pb_ = fmaxf(fmaxf(p0[2], p0[3]), p1[1]); pa_ = fmaxf(fmaxf(pa_, p1[2]), p1[3]);
#pragma unroll
  for (int r = 4; r < 16; r += 4) { pa_ = fmaxf(fmaxf(pa_, p0[r]), p0[r + 1]); pb_ = fmaxf(fmaxf(pb_, p0[r + 2]), p0[r + 3]); pa_ = fmaxf(fmaxf(pa_, p1[r]), p1[r + 1]); pb_ = fmaxf(fmaxf(pb_, p1[r + 2]), p1[r + 3]); }
  float pmax = fmaxf(pa_, pb_);
  { auto rr = __builtin_amdgcn_permlane32_swap(__float_as_uint(pmax), __float_as_uint(pmax), false, false);
    pmax = fmaxf(__uint_as_float(rr[0]), __uint_as_float(rr[1])); }
  if (!FIRST && __builtin_expect(__all(pmax <= THR2), 1)) { alpha = 1.f; }
  else { const float dl = FIRST ? pmax : fmaxf(pmax, 0.f); const float nm = negm[0] - dl;
#pragma unroll
    for (int r = 0; r < 16; ++r) { p0[r] -= dl; p1[r] -= dl; }
#pragma unroll
    for (int r = 0; r < 16; ++r) negm[r] = nm;
    asm volatile("" : "+v"(negm));
    alpha = FIRST ? 1.f : __builtin_amdgcn_exp2f(-dl); }
#pragma unroll
  for (int r = 0; r < 16; ++r) p0[r] = __builtin_amdgcn_exp2f(p0[r]);
}
__device__ __forceinline__ void finishSM(f32x16& p0, f32x16& p1, float alpha, float& l_reg, bf16x8& pa0, bf16x8& pa1, bf16x8& pa2, bf16x8& pa3) {
  for (int r = 0; r < 16; ++r) p1[r] = __builtin_amdgcn_exp2f(p1[r]);
  float ps = 0; for (int r = 0; r < 16; ++r) ps += p0[r]; for (int r = 0; r < 16; ++r) ps += p1[r];
  { auto rr = __builtin_amdgcn_permlane32_swap(__float_as_uint(ps), __float_as_uint(ps), false, false);
    ps = __uint_as_float(rr[0]) + __uint_as_float(rr[1]); }
  l_reg = l_reg * alpha + ps;
#define PK4(P, BASE, OUT) do { unsigned a0 = cvtpk(P[BASE + 0], P[BASE + 1]), a1 = cvtpk(P[BASE + 2], P[BASE + 3]);   \
    unsigned b0 = cvtpk(P[BASE + 4], P[BASE + 5]), b1 = cvtpk(P[BASE + 6], P[BASE + 7]);                              \
    auto r0 = __builtin_amdgcn_permlane32_swap(a0, b0, false, false); auto r1 = __builtin_amdgcn_permlane32_swap(a1, b1, false, false); \
    u32x4 w = {r0[0], r1[0], r0[1], r1[1]}; OUT = *reinterpret_cast<bf16x8*>(&w); } while (0)
  PK4(p0, 0, pa0); PK4(p0, 8, pa1); PK4(p1, 0, pa2); PK4(p1, 8, pa3);
#undef PK4
}
__device__ __forceinline__ void qkt(f32x16& p0, f32x16& p1, const bf16* Ks, const bf16x8* qr, const f32x16& negm, int r32, int hi) {
  const char* kb = (const char*)Ks + r32 * 32 + hi * 16;
#pragma unroll
  for (int d0 = 0; d0 < 8; ++d0) {
    bf16x8 b0 = *reinterpret_cast<const bf16x8*>(kb + d0 * 2048);
    bf16x8 b1 = *reinterpret_cast<const bf16x8*>(kb + d0 * 2048 + 1024);
    if (d0 == 0) { p0 = __builtin_amdgcn_mfma_f32_32x32x16_bf16(b0, qr[0], negm, 0, 0, 0); p1 = __builtin_amdgcn_mfma_f32_32x32x16_bf16(b1, qr[0], negm, 0, 0, 0); }
    else { p0 = __builtin_amdgcn_mfma_f32_32x32x16_bf16(b0, qr[d0], p0, 0, 0, 0); p1 = __builtin_amdgcn_mfma_f32_32x32x16_bf16(b1, qr[d0], p1, 0, 0, 0); } }
}
__device__ __forceinline__ int v_st(int k, int c) { const int kk = (k & ~0xC) | ((k & 4) << 1) | ((k & 8) >> 1); return ((kk >> 3) * 4 + (c >> 5)) * 512 + ((kk & 7) * 32 + (c & 31)) * 2; }
__device__ __forceinline__ int v_rd_base(int lane) { return ((lane & 3) << 3) | (((lane >> 2) & 3) << 6) | (((lane >> 4) & 1) << 5) | (((lane >> 5) & 1) << 8); }
constexpr int v_rd_off(int d0, int ks, int half) { return d0 * 512 + ks * 4096 + half * 2048; }
template <int OFF> __device__ __forceinline__ s16x4 tr_read(int vb) {
  s16x4 r; asm volatile("ds_read_b64_tr_b16 %0, %1 offset:%2" : "=&v"(r) : "v"(vb), "i"(OFF) : "memory"); return r;
}
template <int D0> __device__ __forceinline__ void pv_one(f32x16& od, int vb, bf16x8 pa0, bf16x8 pa1, bf16x8 pa2, bf16x8 pa3) {
  const s16x4 l0 = tr_read<v_rd_off(D0, 0, 0)>(vb), h0 = tr_read<v_rd_off(D0, 0, 1)>(vb), l1 = tr_read<v_rd_off(D0, 1, 0)>(vb), h1 = tr_read<v_rd_off(D0, 1, 1)>(vb);
  const s16x4 l2 = tr_read<v_rd_off(D0, 2, 0)>(vb), h2 = tr_read<v_rd_off(D0, 2, 1)>(vb), l3 = tr_read<v_rd_off(D0, 3, 0)>(vb), h3 = tr_read<v_rd_off(D0, 3, 1)>(vb);
  asm volatile("s_waitcnt lgkmcnt(0)" ::: "memory"); SBAR();
#define PK(L, H) (bf16x8){L[0], L[1], L[2], L[3], H[0], H[1], H[2], H[3]}
  od = __builtin_amdgcn_mfma_f32_32x32x16_bf16(pa0, PK(l0, h0), od, 0, 0, 0);
  od = __builtin_amdgcn_mfma_f32_32x32x16_bf16(pa1, PK(l1, h1), od, 0, 0, 0);
  od = __builtin_amdgcn_mfma_f32_32x32x16_bf16(pa2, PK(l2, h2), od, 0, 0, 0);
  od = __builtin_amdgcn_mfma_f32_32x32x16_bf16(pa3, PK(l3, h3), od, 0, 0, 0);
#undef PK
}
__device__ __forceinline__ void pv_d0(f32x16* o, int vb, bf16x8 pa0, bf16x8 pa1, bf16x8 pa2, bf16x8 pa3) {
  pv_one<0>(o[0], vb, pa0, pa1, pa2, pa3); pv_one<1>(o[1], vb, pa0, pa1, pa2, pa3); pv_one<2>(o[2], vb, pa0, pa1, pa2, pa3); pv_one<3>(o[3], vb, pa0, pa1, pa2, pa3);
}

template <typename TQ>
__device__ __forceinline__ void attn_dense_body(const TQ* __restrict__ Qb, const bf16* __restrict__ Kh, const bf16* __restrict__ Vh,
                                                float* __restrict__ Ob, int seq, char* lds, const float* __restrict__ qnw, const float* __restrict__ tab, int t0) {
  using SQ = Stage<TQ>;
  typedef __attribute__((address_space(3))) unsigned lds_u32;
  const int tid = threadIdx.x, lane = tid & 63, r32 = lane & 31, hi = lane >> 5;
  const int wid = __builtin_amdgcn_readfirstlane(tid >> 6);
  char* K_lds = lds; char* V_lds = lds + 3 * SHM_K;
  float* ws = (float*)(lds + 3 * SHM_V + 3 * SHM_K) + wid * 64; float* li_l = ws; float* al_l = ws + 32;
  float l_reg = 0; f32x16 o[4] = {}; bf16x8 qr[8]; f32x16 negm = {}; asm volatile("" : "+v"(negm));
  const TQ* Qw = Qb + (long)(wid * QBLK + r32) * LDQ + hi * 8;
  {
    const int t = t0 + wid * QBLK + r32; float x[8][8]; float ss = 0.f;
#pragma unroll
    for (int d0 = 0; d0 < 8; ++d0) { const u32x4 raw = *reinterpret_cast<const u32x4*>(Qw + d0 * 16);
#pragma unroll
      for (int k = 0; k < 4; ++k) { x[d0][2 * k] = __uint_as_float(raw[k] << 16); x[d0][2 * k + 1] = __uint_as_float(raw[k] & 0xffff0000u); ss += x[d0][2 * k] * x[d0][2 * k] + x[d0][2 * k + 1] * x[d0][2 * k + 1]; } }
    { auto rr = __builtin_amdgcn_permlane32_swap(__float_as_uint(ss), __float_as_uint(ss), false, false); ss = __uint_as_float(rr[0]) + __uint_as_float(rr[1]); }
    const float rstd = rsqrtf(ss * (1.f / 128.f) + 1e-6f);
#pragma unroll
    for (int d0 = 0; d0 < 8; ++d0) { const float* wp = qnw + d0 * 16 + hi * 8;
#pragma unroll
      for (int e = 0; e < 8; ++e) x[d0][e] *= rstd * wp[e]; }
#pragma unroll
    for (int half = 0; half < 2; ++half) { const int pos = half ? (t & 63) : (t >> 6);
#pragma unroll
      for (int b = 0; b < 2; ++b) { const float* tp = tab + (pos * 32 + b * 16 + hi * 8) * 2;
#pragma unroll
        for (int e = 0; e < 8; ++e) { const float c = tp[2 * e], sn = tp[2 * e + 1]; const float x1 = x[half * 4 + b][e], x2 = x[half * 4 + b + 2][e];
          x[half * 4 + b][e] = (x1 * c - x2 * sn) * QSCALE; x[half * 4 + b + 2][e] = (x2 * c + x1 * sn) * QSCALE; } } }
#pragma unroll
    for (int d0 = 0; d0 < 8; ++d0) { u32x4 w = {cvtpk(x[d0][0], x[d0][1]), cvtpk(x[d0][2], x[d0][3]), cvtpk(x[d0][4], x[d0][5]), cvtpk(x[d0][6], x[d0][7])}; qr[d0] = *reinterpret_cast<bf16x8*>(&w); }
  }
  const int vb0 = (int)(uintptr_t)V_lds + v_rd_base(lane);
  unsigned koff, voff;
  { const int d0 = wid >> 1, row = (wid & 1) * 32 + (lane >> 1), h_ = lane & 1; koff = (unsigned)(row * LDK + d0 * 16 + h_ * 8) * 2u; }
  { const int sub = wid * 2 + (lane >> 5), kk = (sub >> 2) * 8 + ((lane & 31) >> 2), c = (sub & 3) * 32 + (lane & 3) * 8;
    const int k = (kk & ~0xC) | ((kk & 4) << 1) | ((kk & 8) >> 1); voff = (unsigned)(k * LDK + c) * 2u; }
  const __attribute__((address_space(3))) char* kdst = (const __attribute__((address_space(3))) char*)(unsigned)(uintptr_t)(K_lds + wid * 1024);
  const __attribute__((address_space(3))) char* vdst = (const __attribute__((address_space(3))) char*)(unsigned)(uintptr_t)(V_lds + wid * 1024);
#define DMA(k0, off) do { const char* kt_ = (const char*)Kh + (size_t)(k0) * (LDK * 2); const char* vt_ = (const char*)Vh + (size_t)(k0) * (LDK * 2); \
      __builtin_amdgcn_global_load_lds((const unsigned*)(kt_ + koff), (lds_u32*)(kdst + (off)), 16, 0, 0); \
      __builtin_amdgcn_global_load_lds((const unsigned*)(kt_ + 128 + koff), (lds_u32*)(kdst + (off) + 8192), 16, 0, 0); \
      __builtin_amdgcn_global_load_lds((const unsigned*)(vt_ + voff), (lds_u32*)(vdst + (off)), 16, 0, 0); \
      __builtin_amdgcn_global_load_lds((const unsigned*)(vt_ + 32 * LDK * 2 + voff), (lds_u32*)(vdst + (off) + 8192), 16, 0, 0); } while (0)
#define VWAIT() asm volatile("s_waitcnt vmcnt(0)" ::: "memory")
#define RESC(a) do { if (__any((a) < 1.f)) { if (hi == 0) al_l[r32] = (a); asm volatile("s_waitcnt lgkmcnt(0)" ::: "memory"); \
    for (int d = 0; d < 4; ++d) for (int r = 0; r < 16; ++r) o[d][r] *= al_l[crow(r, hi)]; } } while (0)
#define ROT() do { sl_prev = sl_cur; sl_cur = sl_next; sl_next = (sl_next == 2 * (int)SHM_K) ? 0 : sl_next + (int)SHM_K; } while (0)
  f32x16 pA0, pA1, pB0, pB1; float alA, alB; bf16x8 pa0, pa1, pa2, pa3; const int NT = seq / KVBLK;
  DMA(0, 0); DMA(KVBLK, (int)SHM_K); VWAIT(); __syncthreads();
  qkt(pA0, pA1, (const bf16*)K_lds, qr, negm, r32, hi); partialSM<true>(pA0, pA1, negm, alA);
  int sl_prev = 0, sl_cur = (int)SHM_K, sl_next = 2 * (int)SHM_K;
#define STEP(PC0, PC1, ALC, PP0, PP1, ALP, LD, jn1) do { \
    if (LD) { DMA((jn1) * KVBLK, sl_next); } SBAR(); \
    qkt(PC0, PC1, (const bf16*)(K_lds + sl_cur), qr, negm, r32, hi); \
    finishSM(PP0, PP1, ALP, l_reg, pa0, pa1, pa2, pa3); SBAR(); \
    pv_d0(o, vb0 + sl_prev, pa0, pa1, pa2, pa3); partialSM<false>(PC0, PC1, negm, ALC); \
    RESC(ALC); VWAIT(); __syncthreads(); ROT(); } while (0)
  int j = 1;
  for (; j + 2 < NT; j += 2) {
    STEP(pB0, pB1, alB, pA0, pA1, alA, true, j + 1);
    STEP(pA0, pA1, alA, pB0, pB1, alB, true, j + 2);
  }
  STEP(pB0, pB1, alB, pA0, pA1, alA, false, 0);
  finishSM(pB0, pB1, alB, l_reg, pa0, pa1, pa2, pa3); SBAR();
  pv_d0(o, vb0 + sl_prev, pa0, pa1, pa2, pa3);
  if (hi == 0) li_l[r32] = l_reg; asm volatile("s_waitcnt lgkmcnt(0)" ::: "memory");
  float rli[16];
#pragma unroll
  for (int r = 0; r < 16; ++r) rli[r] = __builtin_amdgcn_rcpf(li_l[crow(r, hi)]);
  float* Ow = Ob + (long)(wid * QBLK) * LDO;
#pragma unroll
  for (int r = 0; r < 16; ++r) { int orow = crow(r, hi);
    for (int d0 = 0; d0 < 4; ++d0) Ow[(long)orow * LDO + d0 * 32 + r32] = o[d0][r] * rli[r]; }
#undef DMA
#undef VWAIT
#undef RESC
#undef ROT
#undef STEP
}
#undef KSWZ
#undef SBAR
}
constexpr int M = 16384, DM = 2048, NIN = 4608, AW = 1024, LW = 1024, MIXW = 2048;
constexpr int C_Q = 0, C_K = 1024, C_V = 1280, C_GA = 1536, C_XR = 2560, C_GL = 3584;
constexpr float EPS = 1e-6f;
constexpr int NTHREADS = 512, NWAVES = 8;
constexpr int LDS_BYTES = 131072;
constexpr size_t MiB = 1u << 20;
constexpr size_t WS_WIN = 2 * MiB;
constexpr size_t WS_WOUT = 20 * MiB;
constexpr size_t WS_WG = 28 * MiB;
constexpr size_t WS_TAB = 29 * MiB;
constexpr size_t WS_CARRY = 31 * MiB;
constexpr size_t WS_SUMM = 30 * MiB;
constexpr size_t WS_XN = 32 * MiB;
constexpr size_t WS_PROJ = 96 * MiB;
constexpr size_t WS_O = 240 * MiB;
constexpr size_t WS_HF = 304 * MiB;
constexpr size_t WS_HB = 368 * MiB;
constexpr size_t WS_END = 432 * MiB;

#define LAS __attribute__((address_space(3)))
typedef unsigned short bf16r;
typedef float f32x4 __attribute__((ext_vector_type(4)));
typedef float f32x2 __attribute__((ext_vector_type(2)));
typedef float f32x16 __attribute__((ext_vector_type(16)));
typedef unsigned u32x4 __attribute__((ext_vector_type(4)));
typedef unsigned u32x2 __attribute__((ext_vector_type(2)));
typedef short bf16x8 __attribute__((ext_vector_type(8)));

__device__ __forceinline__ unsigned pk2(float lo, float hi) { unsigned r; asm volatile("v_cvt_pk_bf16_f32 %0, %1, %2" : "=v"(r) : "v"(lo), "v"(hi)); return r; }
__device__ __forceinline__ float bflo(unsigned v) { return __uint_as_float(v << 16); }
__device__ __forceinline__ float bfhi(unsigned v) { return __uint_as_float(v & 0xffff0000u); }
__device__ __forceinline__ float wave_sum(float v) {
#pragma unroll
    for (int o = 1; o < 64; o <<= 1) v += __shfl_xor(v, o);
    return v;
}
__device__ __forceinline__ float sigmoidf_(float z) { return __builtin_amdgcn_rcpf(1.f + __expf(-z)); }

struct Args { const float* in[15]; float* out; unsigned char* ws; int ph_lo, ph_hi; };
enum { I_X = 0, I_NORMW, I_WIN, I_QNW, I_KNW, I_CONVW, I_CONVB, I_WA, I_BA, I_WX, I_BX, I_LAM, I_ANW, I_LNW, I_WOUT };

__device__ __forceinline__ void transpose_item(const float* W, int ldw, int nblk, bf16r* WT, int ldo, LAS float* scr, int item, int lane) {
    const int kb = item / nblk, nb = item % nblk, k0 = 64 * kb, n0 = 32 * nb;
#pragma unroll 8
    for (int i = 0; i < 32; ++i) { const int kk = 2 * i + (lane >> 5); scr[kk * 33 + (lane & 31)] = W[(size_t)(k0 + kk) * ldw + n0 + (lane & 31)]; }
    asm volatile("s_waitcnt lgkmcnt(0)" ::: "memory");
    const int c = lane & 7;
#pragma unroll
    for (int j = 0; j < 4; ++j) { const int n = (lane >> 3) + 8 * j; const LAS float* s = scr + (8 * c) * 33 + n;
        u32x4 o; o.x = pk2(s[0 * 33], s[1 * 33]); o.y = pk2(s[2 * 33], s[3 * 33]); o.z = pk2(s[4 * 33], s[5 * 33]); o.w = pk2(s[6 * 33], s[7 * 33]);
        *(u32x4*)(WT + (size_t)(n0 + n) * ldo + k0 + 8 * c) = o; }
    asm volatile("s_waitcnt lgkmcnt(0)" ::: "memory");
}
__device__ __forceinline__ void p0_prologue(const Args& a, LAS unsigned char* lds, int gw, int NGW, int lane, int wave) {
    unsigned char* ws = a.ws;
    LAS float* scr = (LAS float*)(lds + wave * 16384);
    constexpr int I_IN = (DM / 64) * (NIN / 32), I_OUT = (MIXW / 64) * (DM / 32), I_G = 32 * 8;
    for (int it = gw; it < I_IN + I_OUT + I_G; it += NGW) {
        if (it < I_IN) transpose_item(a.in[I_WIN], NIN, NIN / 32, (bf16r*)(ws + WS_WIN), DM, scr, it, lane);
        else if (it < I_IN + I_OUT) transpose_item(a.in[I_WOUT], DM, DM / 32, (bf16r*)(ws + WS_WOUT), MIXW, scr, it - I_IN, lane);
        else { const int r = it - I_IN - I_OUT, mat = r >> 3, sub = r & 7, which = mat >> 4, db = mat & 15;
            const float* src = (which ? a.in[I_WX] : a.in[I_WA]) + (size_t)db * 128 * 128;
            bf16r* dst = (bf16r*)(ws + WS_WG) + (size_t)db * 256 * 128 + (size_t)which * 128 * 128;
            transpose_item(src, 128, 4, dst, 128, scr, sub, lane); }
    }
    { const int e = gw * 64 + lane;
      if (e < 256 * 32) { const int pos = e >> 5, i = e & 31;
        const float invf = __builtin_amdgcn_exp2f(-(float)i * 0.41524101186092029f);
        const float ang = (float)pos * invf;
        const double ad = (double)ang; const double k = __builtin_rint(ad * 0.63661977236758134);
        const double r = __builtin_fma(-k, 1.5707963267948966, ad); const double r2 = r * r;
        const double sn = r * (1.0 + r2 * (-1.0 / 6 + r2 * (1.0 / 120 + r2 * (-1.0 / 5040 + r2 * (1.0 / 362880 + r2 * (-1.0 / 39916800))))));
        const double cs = 1.0 + r2 * (-0.5 + r2 * (1.0 / 24 + r2 * (-1.0 / 720 + r2 * (1.0 / 40320 + r2 * (-1.0 / 3628800 + r2 * (1.0 / 479001600))))));
        const int q = ((int)k) & 3;
        const double c_ = (q == 0) ? cs : (q == 1) ? -sn : (q == 2) ? -cs : sn;
        const double s_ = (q == 0) ? sn : (q == 1) ? cs : (q == 2) ? -sn : -cs;
        f32x2 o; o.x = (float)c_; o.y = (float)s_; ((f32x2*)(ws + WS_TAB))[e] = o; } }
    const float* x = a.in[I_X]; const f32x4* nw = (const f32x4*)a.in[I_NORMW] + lane;
    for (int m = gw; m < M; m += NGW) {
        const f32x4* xr = (const f32x4*)(x + (size_t)m * DM) + lane; f32x4 v[8]; float s = 0.f;
#pragma unroll
        for (int j = 0; j < 8; ++j) { v[j] = xr[64 * j]; s += (v[j].x * v[j].x + v[j].y * v[j].y) + (v[j].z * v[j].z + v[j].w * v[j].w); }
        const float rstd = rsqrtf(wave_sum(s) * (1.f / DM) + EPS);
        u32x2* o8 = (u32x2*)((bf16r*)(ws + WS_XN) + (size_t)m * DM) + lane;
#pragma unroll
        for (int j = 0; j < 8; ++j) { const f32x4 w = nw[64 * j]; u32x2 o; o.x = pk2(v[j].x * rstd * w.x, v[j].y * rstd * w.y); o.y = pk2(v[j].z * rstd * w.z, v[j].w * rstd * w.w); o8[64 * j] = o; }
    }
}

__device__ __forceinline__ void p2_qkprep(const Args& a, int gw, int NGW, int lane) {
    bf16r* proj = (bf16r*)(a.ws + WS_PROJ); const float* tab = (const float*)(a.ws + WS_TAB);
    const f32x2 kw = ((const f32x2*)a.in[I_KNW])[lane];
    const int i0 = (2 * lane) & 31; const float sgn = (lane & 16) ? 1.f : -1.f;
    for (int t0 = gw; t0 < M; t0 += 4 * NGW) {
        unsigned v[4][2]; f32x4 cs[4]; unsigned* rowp[4];
#pragma unroll
        for (int q = 0; q < 4; ++q) { const int t = min(t0 + q * NGW, M - 1); const int pos = (lane < 32) ? (t >> 6) : (t & 63);
            cs[q] = *(const f32x4*)(tab + (pos * 32 + i0) * 2);
            rowp[q] = (unsigned*)(proj + (size_t)t * NIN + C_K) + lane; v[q][0] = rowp[q][0]; v[q][1] = rowp[q][64]; }
#pragma unroll
        for (int q = 0; q < 4; ++q) { if (t0 + q * NGW >= M) break;
#pragma unroll
            for (int hh = 0; hh < 2; ++hh) {
                const float x0 = bflo(v[q][hh]), x1 = bfhi(v[q][hh]);
                const float rstd = rsqrtf(wave_sum(x0 * x0 + x1 * x1) * (1.f / 128.f) + EPS);
                const float y0 = x0 * rstd * kw.x, y1 = x1 * rstd * kw.y;
                const float p0 = __shfl_xor(y0, 16), p1 = __shfl_xor(y1, 16);
                rowp[q][hh * 64] = pk2(y0 * cs[q].x + sgn * p0 * cs[q].y, y1 * cs[q].z + sgn * p1 * cs[q].w); } }
    }
}

constexpr int L_SUM = 0, L_CW = 8192, L_WT = 16384;
#define KSWZ_(row, colB) ((row) * 256 + ((colB) ^ (((row) & 7) << 4)))
__device__ __forceinline__ int crow_(int r, int hi) { return (r & 3) + 8 * (r >> 2) + 4 * hi; }
template <int DIR>
__device__ __forceinline__ void lru_unit(const Args& a, LAS unsigned char* lds, int ck, int blk, bool load_w) {
    int tid = threadIdx.x; asm volatile("" : "+v"(tid));
    const int lane = tid & 63, r32 = lane & 31, hi = lane >> 5;
    const int w = __builtin_amdgcn_readfirstlane(tid >> 6);
    constexpr int d = DIR;
    unsigned char* ws = a.ws;
    const bf16r* proj = (const bf16r*)(ws + WS_PROJ);
    LAS float* CWl = (LAS float*)(lds + L_CW);
    LAS f32x2* SUM = (LAS f32x2*)(lds + L_SUM);
    __syncthreads();
    if (load_w) {
        const bf16r* Wt = (const bf16r*)(ws + WS_WG) + (size_t)(d * 8 + blk) * 256 * 128;
#pragma unroll
        for (int i = 0; i < 8; ++i) { const int p = tid + 512 * i, row = p >> 4, c16 = p & 15;
            const u32x4 v = *(const u32x4*)(Wt + row * 128 + c16 * 8); *(LAS u32x4*)(lds + L_WT + KSWZ_(row, c16 * 16)) = v; }
        const float* cw = a.in[I_CONVW]; const float* cbias = a.in[I_CONVB];
        for (int e = tid; e < 640; e += 512) CWl[e] = e < 512 ? cw[(e >> 7) * 1024 + blk * 128 + (e & 127)] : cbias[blk * 128 + (e - 512)];
    }
    __syncthreads();
    const int t = ck * 256 + w * 32 + r32;
    bf16x8 A[8];
#pragma unroll
    for (int kk = 0; kk < 8; ++kk) { const int c0 = kk * 16 + hi * 8;
        f32x4 acc0 = *(const LAS f32x4*)(CWl + 512 + c0), acc1 = *(const LAS f32x4*)(CWl + 512 + c0 + 4);
#pragma unroll
        for (int j = 0; j < 4; ++j) { const int tt = t + j - 2; const bool ok = tt >= 0 && tt < M; const int tc = ok ? tt : t;
            u32x4 xv = *(const u32x4*)(proj + (size_t)tc * NIN + C_XR + blk * 128 + c0);
            if (!ok) xv = (u32x4){0u, 0u, 0u, 0u};
            const f32x4 w0 = *(const LAS f32x4*)(CWl + j * 128 + c0), w1 = *(const LAS f32x4*)(CWl + j * 128 + c0 + 4);
            acc0.x += w0.x * bflo(xv.x); acc0.y += w0.y * bfhi(xv.x); acc0.z += w0.z * bflo(xv.y); acc0.w += w0.w * bfhi(xv.y);
            acc1.x += w1.x * bflo(xv.z); acc1.y += w1.y * bfhi(xv.z); acc1.z += w1.z * bflo(xv.w); acc1.w += w1.w * bfhi(xv.w); }
        u32x4 o; o.x = pk2(acc0.x, acc0.y); o.y = pk2(acc0.z, acc0.w); o.z = pk2(acc1.x, acc1.y); o.w = pk2(acc1.z, acc1.w);
        A[kk] = __builtin_bit_cast(bf16x8, o); if ((kk & 3) == 3) asm volatile("" ::: "memory"); }
    bf16x8 Bid[2];
#pragma unroll
    for (int kq = 0; kq < 2; ++kq)
#pragma unroll
        for (int j = 0; j < 8; ++j) Bid[kq][j] = (16 * kq + 8 * hi + j == r32) ? (short)0x3F80 : (short)0;
    unsigned* hcout = (unsigned*)(ws + (d ? WS_HB : WS_HF));
#pragma unroll
    for (int rd = 0; rd < 4; ++rd) {
        float hl[1][16], cq[1][16];
#pragma unroll
        for (int cc = 0; cc < 1; ++cc) { const int ct = rd + cc;
            f32x16 accr = {}, acci = {}, accx = {};
#pragma unroll
            for (int kk = 0; kk < 8; ++kk) {
                const bf16x8 br = *(const LAS bf16x8*)(lds + L_WT + KSWZ_(ct * 32 + r32, (kk * 16 + hi * 8) * 2));
                const bf16x8 bi = *(const LAS bf16x8*)(lds + L_WT + KSWZ_(128 + ct * 32 + r32, (kk * 16 + hi * 8) * 2));
                accr = __builtin_amdgcn_mfma_f32_32x32x16_bf16(A[kk], br, accr, 0, 0, 0);
                acci = __builtin_amdgcn_mfma_f32_32x32x16_bf16(A[kk], bi, acci, 0, 0, 0);
            }
            accx = __builtin_amdgcn_mfma_f32_32x32x16_bf16(A[2 * ct], Bid[0], accx, 0, 0, 0);
            accx = __builtin_amdgcn_mfma_f32_32x32x16_bf16(A[2 * ct + 1], Bid[1], accx, 0, 0, 0);
            const int cidx = d * 1024 + blk * 128 + ct * 32 + r32;
            const float ba = a.in[I_BA][cidx], bx = a.in[I_BX][cidx], lam = a.in[I_LAM][cidx];
            const float sp8 = 8.f * log1pf(__expf(-lam));
            float av[16], bv[16];
#pragma unroll
            for (int r = 0; r < 16; ++r) {
                const float rg = __builtin_amdgcn_rcpf(1.f + __builtin_amdgcn_exp2f(-1.4426950408889634f * (accr[r] + ba)));
                const float ig = __builtin_amdgcn_rcpf(1.f + __builtin_amdgcn_exp2f(-1.4426950408889634f * (acci[r] + bx)));
                const float la = -sp8 * rg; const float aa = __builtin_amdgcn_exp2f(1.4426950408889634f * la);
                const float om = __builtin_fmaf(-aa, aa, 1.f);
                av[r] = aa; bv[r] = __builtin_amdgcn_sqrtf(om) * ig * accx[r];
            }
            float Pg[4], Hg[4];
#pragma unroll
            for (int g = 0; g < 4; ++g) { float h = 0.f, cp = 1.f;
#pragma unroll
                for (int e = 0; e < 4; ++e) { const int r = 4 * g + (DIR == 0 ? e : 3 - e); h = av[r] * h + bv[r]; cp *= av[r]; bv[r] = h; av[r] = cp; }
                Pg[g] = cp; Hg[g] = h; }
            float F = 1.f, E = 0.f, Fg[4], Eg[4];
#pragma unroll
            for (int gi = 0; gi < 4; ++gi) { const int g = DIR == 0 ? gi : 3 - gi;
                const float pP = __shfl_xor(Pg[g], 32), pH = __shfl_xor(Hg[g], 32);
                const float Pe = hi ? pP : Pg[g], He = hi ? pH : Hg[g];
                const float Po = hi ? Pg[g] : pP, Ho = hi ? Hg[g] : pH;
                if (DIR == 0) { const float F1 = Pe * F, E1 = Pe * E + He; Fg[g] = hi ? F1 : F; Eg[g] = hi ? E1 : E; F = Po * F1; E = Po * E1 + Ho; }
                else          { const float F1 = Po * F, E1 = Po * E + Ho; Fg[g] = hi ? F : F1; Eg[g] = hi ? E : E1; F = Pe * F1; E = Pe * E1 + He; } }
            if (hi == 0) { f32x2 o; o.x = F; o.y = E; SUM[(rd * 8 + w) * 32 + r32] = o; }
#pragma unroll
            for (int r = 0; r < 16; ++r) { hl[cc][r] = bv[r] + av[r] * Eg[r >> 2]; cq[cc][r] = av[r] * Fg[r >> 2]; }
        }
        __syncthreads();
        {
            const int ct = rd; float Fw = 1.f, Ew = 0.f;
            if (DIR == 0) { for (int wp = 0; wp < w; ++wp) { const f32x2 fe = SUM[(rd * 8 + wp) * 32 + r32]; Ew = fe.x * Ew + fe.y; Fw *= fe.x; } }
            else          { for (int wp = 7; wp > w; --wp) { const f32x2 fe = SUM[(rd * 8 + wp) * 32 + r32]; Ew = fe.x * Ew + fe.y; Fw *= fe.x; } }
            const size_t o0 = (size_t)(ck * 256 + w * 32) * LW + blk * 128 + ct * 32 + r32;
#pragma unroll
            for (int r = 0; r < 16; ++r) { const size_t oo = o0 + (size_t)crow_(r, hi) * LW;
                hcout[oo] = pk2(hl[0][r] + cq[0][r] * Ew, cq[0][r] * Fw); }
        }
        if (tid < 32) {
            float F = 1.f, E = 0.f;
#pragma unroll
            for (int wi = 0; wi < 8; ++wi) { const int wp = DIR == 0 ? wi : 7 - wi; const f32x2 fe = SUM[(rd * 8 + wp) * 32 + tid]; E = fe.x * E + fe.y; F *= fe.x; }
            f32x2 o; o.x = F; o.y = E; ((f32x2*)(ws + WS_SUMM))[(ck * 2 + d) * 1024 + blk * 128 + rd * 32 + tid] = o;
        }
    }
}
__device__ __forceinline__ void lru_phase(const Args& a, LAS unsigned char* lds, int bid, int G, int nrep) {
    const int key = bid & 15, d = key & 1, blk = key >> 1, ck0 = bid >> 4, dck = G >> 4;
    if (d == 0) { bool first = true; for (int c_ = ck0; c_ < 64 * nrep; c_ += dck) { lru_unit<0>(a, lds, c_ & 63, blk, first); first = false; } }
    else        { bool first = true; for (int c_ = ck0; c_ < 64 * nrep; c_ += dck) { lru_unit<1>(a, lds, c_ & 63, blk, first); first = false; } }
    __syncthreads();
}
__device__ __forceinline__ void carry_phase(const Args& a, int gw, int NGW, int lane) {
    const f32x2* summ = (const f32x2*)(a.ws + WS_SUMM); float* carry = (float*)(a.ws + WS_CARRY);
    for (int ch = gw; ch < 2048; ch += NGW) { const int d = ch >> 10, c = ch & 1023, kk = d ? 63 - lane : lane;
        const f32x2 s = summ[(kk * 2 + d) * 1024 + c]; float P = s.x, H = s.y;
#pragma unroll
        for (int off = 1; off < 64; off <<= 1) { const float Pp = __shfl_up(P, off), Hp = __shfl_up(H, off); if (lane >= off) { H = P * Hp + H; P = P * Pp; } }
        const float cin = __shfl_up(H, 1);
        carry[(kk * 2 + d) * 1024 + c] = lane ? cin : 0.f; }
}

__device__ __forceinline__ void p4_mix(const Args& a, int gw, int NGW, int lane) {
    unsigned char* ws = a.ws;
    const bf16r* proj = (const bf16r*)(ws + WS_PROJ); bf16r* mixed = (bf16r*)(ws + WS_XN);
    const float* O = (const float*)(ws + WS_O);
    const unsigned* HCF = (const unsigned*)(ws + WS_HF); const unsigned* HCB = (const unsigned*)(ws + WS_HB);
    const float* carry = (const float*)(ws + WS_CARRY);
    const f32x4* anw = (const f32x4*)a.in[I_ANW] + lane; const f32x4* lnw = (const f32x4*)a.in[I_LNW] + lane;
    for (int b8 = gw; b8 < M / 8; b8 += NGW) {
        const int ck = b8 >> 5; f32x4 cf[4], cb[4];
#pragma unroll
        for (int j = 0; j < 4; ++j) { cf[j] = ((const f32x4*)(carry + (ck * 2 + 0) * 1024) + lane)[64 * j]; cb[j] = ((const f32x4*)(carry + (ck * 2 + 1) * 1024) + lane)[64 * j]; }
        for (int rr = 0; rr < 8; ++rr) { const int m = b8 * 8 + rr;
        f32x4 v[4], u[4]; float s1 = 0.f, s2 = 0.f;
#pragma unroll
        for (int j = 0; j < 4; ++j) {
            v[j] = ((const f32x4*)(O + (size_t)m * AW) + lane)[64 * j];
            const u32x4 f = ((const u32x4*)(HCF + (size_t)m * LW) + lane)[64 * j], b = ((const u32x4*)(HCB + (size_t)m * LW) + lane)[64 * j];
            u[j].x = (bflo(f.x) + bfhi(f.x) * cf[j].x) + (bflo(b.x) + bfhi(b.x) * cb[j].x);
            u[j].y = (bflo(f.y) + bfhi(f.y) * cf[j].y) + (bflo(b.y) + bfhi(b.y) * cb[j].y);
            u[j].z = (bflo(f.z) + bfhi(f.z) * cf[j].z) + (bflo(b.z) + bfhi(b.z) * cb[j].z);
            u[j].w = (bflo(f.w) + bfhi(f.w) * cf[j].w) + (bflo(b.w) + bfhi(b.w) * cb[j].w);
            s1 += (v[j].x * v[j].x + v[j].y * v[j].y) + (v[j].z * v[j].z + v[j].w * v[j].w);
            s2 += (u[j].x * u[j].x + u[j].y * u[j].y) + (u[j].z * u[j].z + u[j].w * u[j].w); }
        const float r1 = rsqrtf(wave_sum(s1) * (1.f / AW) + EPS), r2 = rsqrtf(wave_sum(s2) * (1.f / LW) + EPS);
        const u32x2* ga = (const u32x2*)(proj + (size_t)m * NIN + C_GA) + lane; const u32x2* gl = (const u32x2*)(proj + (size_t)m * NIN + C_GL) + lane;
        u32x2* mo = (u32x2*)(mixed + (size_t)m * MIXW) + lane;
#pragma unroll
        for (int j = 0; j < 4; ++j) {
            { const u32x2 g = ga[64 * j]; const f32x4 w = anw[64 * j];
              const float g0 = bflo(g.x), g1 = bfhi(g.x), g2 = bflo(g.y), g3 = bfhi(g.y);
              u32x2 o; o.x = pk2(v[j].x * r1 * w.x * g0 * sigmoidf_(g0), v[j].y * r1 * w.y * g1 * sigmoidf_(g1));
              o.y = pk2(v[j].z * r1 * w.z * g2 * sigmoidf_(g2), v[j].w * r1 * w.w * g3 * sigmoidf_(g3)); mo[64 * j] = o; }
            { const u32x2 g = gl[64 * j]; const f32x4 w = lnw[64 * j];
              const float g0 = bflo(g.x), g1 = bfhi(g.x), g2 = bflo(g.y), g3 = bfhi(g.y);
              u32x2 o; o.x = pk2(u[j].x * r2 * w.x * g0 * sigmoidf_(g0), u[j].y * r2 * w.y * g1 * sigmoidf_(g1));
              o.y = pk2(u[j].z * r2 * w.z * g2 * sigmoidf_(g2), u[j].w * r2 * w.w * g3 * sigmoidf_(g3)); mo[256 + 64 * j] = o; }
        }
        }
    }
}

#define RLX_AGENT __ATOMIC_RELAXED, __HIP_MEMORY_SCOPE_AGENT
#define XB_TMO      128
#define XB_XCNT(j)  (256  + 64 * (j))
#define XB_XSUB(j)  (1280 + 64 * (j))
#define XB_XGEN(j)  (2304 + 64 * (j))
#define XB_TOP      3328
#define XB_TOPGEN   3392
#define XCD_BAR_WORDS 3456
#define XB_SPIN_CAP (1u << 18)

__device__ __forceinline__ unsigned xb_ld(unsigned* p)              { return __hip_atomic_load(p, __ATOMIC_RELAXED, __HIP_MEMORY_SCOPE_AGENT); }
__device__ __forceinline__ unsigned xb_add(unsigned* p, unsigned v) { return __hip_atomic_fetch_add(p, v, __ATOMIC_RELAXED, __HIP_MEMORY_SCOPE_AGENT); }
__device__ __forceinline__ unsigned xb_xcc_id() { return (unsigned)__builtin_amdgcn_s_getreg((3 << 11) | 20) & 0xFu; }
#define XB_SPIN(cond, bar) do { unsigned _sp = 0; while (cond) { __builtin_amdgcn_s_sleep(1); \
    if ((++_sp & 255u) == 0u) { if (xb_ld(&(bar)[XB_TMO])) break; if (_sp > XB_SPIN_CAP) { atomicAdd(&(bar)[XB_TMO], 1u); break; } } } } while (0)

struct XcdBarrier {
    unsigned* bar; unsigned x;
    volatile LAS unsigned* st;
};

__device__ __forceinline__ XcdBarrier xcd_barrier_post(unsigned* bar, volatile LAS unsigned* st) {
    XcdBarrier b; b.bar = bar; b.x = xb_xcc_id(); b.st = st;
    if (threadIdx.x == 0) (void)xb_add(&bar[XB_XCNT(b.x)], 1u);
    return b;
}
__device__ __forceinline__ void xcd_barrier_complete(unsigned* bar, unsigned x, unsigned& nloc, unsigned& nx) {
    const unsigned G = gridDim.x * gridDim.y * gridDim.z;
    unsigned sum, cnt, mine, sp = 0u;
    for (;;) {
        sum = 0u; cnt = 0u; mine = 0u;
#pragma unroll
        for (unsigned j = 0; j < 16; ++j) { const unsigned c = xb_ld(&bar[XB_XCNT(j)]); sum += c; cnt += (c > 0u) ? 1u : 0u; mine = (j == x) ? c : mine; }
        if (sum == G) break;
        __builtin_amdgcn_s_sleep(1);
        if ((++sp & 255u) == 0u) { if (xb_ld(&bar[XB_TMO])) break; if (sp > XB_SPIN_CAP) { atomicAdd(&bar[XB_TMO], 1u); break; } }
    }
    nloc = mine > 0u ? mine : 1u; nx = cnt > 0u ? cnt : 1u;
}

__device__ __forceinline__ void xcd_barrier(const XcdBarrier& b) {
    asm volatile("s_waitcnt vmcnt(0)" ::: "memory");
    __syncthreads();
    if (threadIdx.x == 0) {
        unsigned* bar = b.bar;
        __builtin_amdgcn_s_waitcnt(0);
        unsigned nloc = b.st[0], nx = b.st[1];
        if (nloc == 0u) { xcd_barrier_complete(bar, b.x, nloc, nx); b.st[0] = nloc; b.st[1] = nx; }
        const unsigned old = xb_add(&bar[XB_XSUB(b.x)], 1u);
        const unsigned gen = old / nloc;
        if (old + 1u == (gen + 1u) * nloc) {
            __builtin_amdgcn_fence(__ATOMIC_RELEASE, "agent");
            asm volatile("s_waitcnt vmcnt(0)" ::: "memory");
            const unsigned og = xb_add(&bar[XB_TOP], 1u);
            const unsigned tg = og / nx;
            if (og + 1u == (tg + 1u) * nx) xb_add(&bar[XB_TOPGEN], 1u);
            else XB_SPIN(xb_ld(&bar[XB_TOPGEN]) == tg, bar);
            __builtin_amdgcn_fence(__ATOMIC_ACQUIRE, "agent");
            xb_add(&bar[XB_XGEN(b.x)], 1u);
            asm volatile("s_waitcnt vmcnt(0)" ::: "memory");
        } else {
            XB_SPIN(xb_ld(&bar[XB_XGEN(b.x)]) == gen, bar);
            __builtin_amdgcn_fence(__ATOMIC_ACQUIRE, "agent");
            asm volatile("s_waitcnt vmcnt(0)" ::: "memory");
        }
    }
    __syncthreads();
}

__global__ void __launch_bounds__(NTHREADS) hybrid_fwd(Args args) {
    extern __shared__ __attribute__((aligned(16))) unsigned char lds_raw[];
    LAS unsigned char* lds = (LAS unsigned char*)lds_raw;
    __shared__ __attribute__((aligned(16))) unsigned xb_st[4];
    cg::grid_group grid = cg::this_grid();
    const int tid = threadIdx.x, lane = tid & 63, wave = __builtin_amdgcn_readfirstlane(tid >> 6);
    if (tid < 4) xb_st[tid] = 0u;
    __syncthreads();
    const XcdBarrier xbar = xcd_barrier_post((unsigned*)args.ws, (volatile LAS unsigned*)xb_st);
    const int G = gridDim.x, bid = blockIdx.x;
    const int gw = bid * NWAVES + wave, NGW = G * NWAVES;
    unsigned char* ws = args.ws;
    const int lo = args.ph_lo, hi = args.ph_hi;
#define IN(k) (lo <= (k) && (k) < hi)
#ifndef REP
#define REP -1
#endif
#define NREP(k) ((REP) == (k) ? 2 : 1)
#define SEAM(k) do { if (IN(k) && IN((k) + 1)) xcd_barrier(xbar); } while (0)
    if (lo > hi) grid.sync();

    if (IN(0)) { p0_prologue(args, lds, gw, NGW, lane, wave); __syncthreads(); }
    SEAM(0);
    if (IN(1)) {
        pg8::Gemm g{(const pg8::bf16_t*)(ws + WS_XN), (const pg8::bf16_t*)(ws + WS_WIN), M, NIN, DM}; pg8::StaticOrder S; S.init(M, NIN, G, bid);
        constexpr int NU = (M / 256) * (NIN / 256);
        const int nfull = (G == 256) ? (NU / 256) * 256 : NU;
        S.lend = nfull;
        pg8::EpiStoreBf16 E{(pg8::bf16_t*)(ws + WS_PROJ), NIN};
        pg8::gemm_phase<pg8::EpiStoreBf16, pg8::StaticOrder, true, true>(lds, g, S, E);
        __syncthreads();
        if (nfull < NU) {
            const int slot = bid & 127, half = bid >> 7;
            pg8::StaticOrder S2; S2.init(M, NIN, G, 0); S2.lbeg = nfull + slot; S2.lend = nfull + slot + 1;
            pg8::EpiStoreBf16Half E2{(pg8::bf16_t*)(ws + WS_PROJ), NIN, half};
            pg8::gemm_phase<pg8::EpiStoreBf16Half, pg8::StaticOrder, true, true, 1>(lds, g, S2, E2, (size_t)half * pg8::HALF * DM * 2);
            __syncthreads();
        }
    }
    SEAM(1);
    if (IN(2)) p2_qkprep(args, gw, NGW, lane);
    SEAM(2);
    if (IN(3)) {
        const att::bf16* proj = (const att::bf16*)(ws + WS_PROJ);
        for (int u = bid; u < 512; u += G) { const int h = u >> 6, qb = u & 63, kvh = h >> 2;
            att::attn_dense_body<att::bf16>(proj + (size_t)qb * 256 * NIN + C_Q + h * 128, proj + C_K + kvh * 128, proj + C_V + kvh * 128,
                                            (float*)(ws + WS_O) + (size_t)qb * 256 * AW + h * 128, M, (char*)lds_raw, args.in[I_QNW], (const float*)(ws + WS_TAB), qb * 256);
            __syncthreads(); }
        lru_phase(args, lds, bid, G, 1);
    }
    SEAM(3);
    if (IN(4)) carry_phase(args, gw, NGW, lane);
    SEAM(4);
    if (IN(5)) p4_mix(args, gw, NGW, lane);
    SEAM(5);
    if (IN(6)) {
        pg8::Gemm g{(const pg8::bf16_t*)(ws + WS_XN), (const pg8::bf16_t*)(ws + WS_WOUT), M, DM, MIXW}; pg8::StaticOrder S; S.init(M, DM, G, bid);
        pg8::EpiResidual E{args.in[I_X], args.out, DM};
        pg8::gemm_phase<pg8::EpiResidual, pg8::StaticOrder, true, true>(lds, g, S, E);
    }
#undef IN
#undef SEAM
}

#ifndef N_LAUNCHES
#define N_LAUNCHES 1
#endif
extern "C" void kernel_launch(void* const* d_in, const int* in_sizes, int n_in, void* d_out, int out_size, void* d_ws, size_t ws_size, hipStream_t stream) {
    static int grid = 0;
    if (grid == 0) {
        if (n_in != 15 || in_sizes[0] != M * DM || out_size != M * DM || ws_size < WS_END) { fprintf(stderr, "kernel_launch: shape/workspace mismatch (n_in %d, ws %zu)\n", n_in, ws_size); grid = -1; return; }
        int dev = 0, cus = 0, per_cu = 0;
        (void)hipGetDevice(&dev); (void)hipDeviceGetAttribute(&cus, hipDeviceAttributeMultiprocessorCount, dev);
        if (hipFuncSetAttribute((const void*)hybrid_fwd, hipFuncAttributeMaxDynamicSharedMemorySize, LDS_BYTES) != hipSuccess) { fprintf(stderr, "kernel_launch: hipFuncSetAttribute failed\n"); grid = -1; return; }
        if (hipOccupancyMaxActiveBlocksPerMultiprocessor(&per_cu, (const void*)hybrid_fwd, NTHREADS, LDS_BYTES) != hipSuccess || per_cu < 1) { fprintf(stderr, "kernel_launch: occupancy query gave %d\n", per_cu); per_cu = 1; }
        (void)hipGetLastError();
        grid = cus * 1;
    }
    if (grid < 0) return;
    Args a{};
    for (int i = 0; i < 15; ++i) a.in[i] = (const float*)d_in[i];
    a.out = (float*)d_out; a.ws = (unsigned char*)d_ws;
    if (hipMemsetAsync(d_ws, 0, 16384, stream) != hipSuccess) { fprintf(stderr, "kernel_launch: hipMemsetAsync failed\n"); return; }
    if (N_LAUNCHES == 1) {
        a.ph_lo = 0; a.ph_hi = 7;
        void* kargs[] = {&a};
        hipError_t e = hipLaunchCooperativeKernel((const void*)hybrid_fwd, dim3(grid), dim3(NTHREADS), kargs, LDS_BYTES, stream);
        if (e != hipSuccess) fprintf(stderr, "cooperative launch failed: %s (grid %d)\n", hipGetErrorString(e), grid);
    } else {
        for (int p = 0; p < 7; ++p) { a.ph_lo = p; a.ph_hi = p + 1; hipLaunchKernelGGL(hybrid_fwd, dim3(grid), dim3(NTHREADS), LDS_BYTES, stream, a); }
    }
}
```

```cpp
#include <hip/hip_runtime.h>
#include <hip/hip_bf16.h>
#include <hip/hip_cooperative_groups.h>
#include <cstdio>
#include <cstdint>
namespace cg = cooperative_groups;
namespace pg8 {
#define PG8_LAS __attribute__((address_space(3)))
typedef unsigned short bf16_t;
typedef short bf16x8 __attribute__((ext_vector_type(8)));
typedef float f32x4 __attribute__((ext_vector_type(4)));
typedef unsigned u32x4 __attribute__((ext_vector_type(4)));
constexpr int BM = 256, BK = 64, HALF = 128, HTB = HALF * BK * 2  , STAGE_BYTES = 8 * HTB, NXCD = 8, WGM = 8;

__host__ __device__ __forceinline__ int lds_byte(int r, int c) { const int st = (r >> 4) * 2 + (c >> 5), rr = r & 15, cc = c & 31, ob = rr * 64 + cc * 2; return st * 1024 + (ob ^ (((ob >> 9) & 1) << 5)); }
__host__ __device__ __forceinline__ void stage_rc(int b, int& R, int& C) { const int st = b / 1024, sb = b % 1024, swz = sb ^ (((sb >> 9) & 1) << 5); R = (st >> 1) * 16 + swz / 64; C = (st & 1) * 32 + (swz % 64) / 2; }
__host__ __device__ __forceinline__ int perm32(int rho) { const int n = rho >> 4, i = rho & 15; return 8 * (i >> 2) + 4 * n + (i & 3); }

struct Unit { int pm, pn; };
struct Gemm { const bf16_t* A; const bf16_t* Bt; int M, N, K; };

struct StaticOrder {
    int nM, nN, nwg, G, c;
    __host__ __device__ void init(int M, int N, int G_, int c_) { nM = M / BM; nN = N / BM; nwg = nM * nN; G = G_; c = c_; }
    __host__ __device__ bool next(int i, Unit& u) const {
        const long L = (long)i * G + c; if (L >= nwg) return false;
        int wgid = (int)L; { const int q = nwg / NXCD, r = nwg % NXCD, xcd = wgid % NXCD, off = wgid / NXCD; wgid = (xcd < r ? xcd * (q + 1) : r * (q + 1) + (xcd - r) * q) + off; }
        const int nig = WGM * nN, gid = wgid / nig, fm = gid * WGM, gsz = (nM - fm) < WGM ? (nM - fm) : WGM;
        u.pm = fm + ((wgid % nig) % gsz); u.pn = (wgid % nig) / gsz; return true;
    }
    __device__ __forceinline__ void a_ready(const Unit&) const {}
    __device__ __forceinline__ void done(const Unit&) const {}
};

__device__ __forceinline__ unsigned cvt_pk_bf16(float lo, float hi) { unsigned r; asm volatile("v_cvt_pk_bf16_f32 %0, %1, %2" : "=v"(r) : "v"(lo), "v"(hi)); return r; }
__device__ __forceinline__ void store16_wt(void* p, u32x4 v) { asm volatile("global_store_dwordx4 %0, %1, off sc1" :: "v"(p), "v"(v) : "memory"); }
struct EpiStoreBf16 {
    static constexpr bool PERM = true, AFTER_DRAIN = false;
    bf16_t* O; int ldc;
    __device__ __forceinline__ void operator()(const f32x4 (&acc)[2][2][4][2], const Unit& u, int wr, int wc, int fr, int fq) const {
        const int row0 = u.pm * BM + wr * 64 + fr; const int col0 = u.pn * BM + wc * 32 + 8 * fq;
#pragma unroll
        for (int ai = 0; ai < 2; ++ai)
#pragma unroll
            for (int m = 0; m < 4; ++m) { bf16_t* rowp = O + (size_t)(row0 + ai * HALF + m * 16) * ldc + col0;
#pragma unroll
                for (int bj = 0; bj < 2; ++bj) { const f32x4 v0 = acc[ai][bj][m][0], v1 = acc[ai][bj][m][1];
                    u32x4 w; w.x = cvt_pk_bf16(v0[0], v0[1]); w.y = cvt_pk_bf16(v0[2], v0[3]); w.z = cvt_pk_bf16(v1[0], v1[1]); w.w = cvt_pk_bf16(v1[2], v1[3]);
                    store16_wt(rowp + bj * HALF, w); } }
    }
};
struct EpiResidual {
    static constexpr bool PERM = false, AFTER_DRAIN = false;
    const float* x; float* out; int ldc;
    __device__ __forceinline__ void operator()(const f32x4 (&acc)[2][2][4][2], const Unit& u, int wr, int wc, int fr, int fq) const {
        const int row0 = u.pm * BM + wr * 64 + fr; const int col0 = u.pn * BM + wc * 32 + 4 * fq;
#pragma unroll
        for (int ai = 0; ai < 2; ++ai)
#pragma unroll
            for (int m = 0; m < 4; ++m) { const size_t off = (size_t)(row0 + ai * HALF + m * 16) * ldc + col0;
#pragma unroll
                for (int bj = 0; bj < 2; ++bj)
#pragma unroll
                    for (int n = 0; n < 2; ++n) { const f32x4 xv = *(const f32x4*)(x + off + bj * HALF + n * 16); *(f32x4*)(out + off + bj * HALF + n * 16) = xv + acc[ai][bj][m][n]; } }
    }
};
template <class Epi, class Sched, bool ALIGN_EPI = false, bool SP2 = false>
__device__ __forceinline__ void gemm_phase(PG8_LAS unsigned char* lds, const Gemm g, const Sched& S, const Epi& E) {
    const int tid = threadIdx.x, wid = __builtin_amdgcn_readfirstlane(tid >> 6), lane = tid & 63, wr = wid >> 2, wc = wid & 3, fr = lane & 15, fq = lane >> 4;
    const int K = g.K, nt = K / BK;
    unsigned voffA[2], voffB[2];
#pragma unroll
    for (int i = 0; i < 2; ++i) { int R, C; stage_rc(tid * 16 + i * 8192, R, C); const int Rb = Epi::PERM ? ((R & ~31) + perm32(R & 31)) : R;
        voffA[i] = (unsigned)(R * K + C) * 2u; voffB[i] = (unsigned)(Rb * K + C) * 2u; }
    const size_t kstep = (size_t)(BK * 2);
    const size_t hstep = (size_t)HALF * K * 2;
    const size_t tstep = 2 * hstep;
    const unsigned ldsw = (unsigned)wid * 1024u;
    const int aoff = lds_byte(wr * 64 + fr, fq * 8), boff = lds_byte(wc * 32 + fr, fq * 8);
#define PG8_SA(b, h) (((b) * 2 + (h)) * HTB)
#define PG8_SB(b, h) ((4 + (b) * 2 + (h)) * HTB)
#define PG8_STAGE(bufoff, gbase, voff) do { _Pragma("unroll") for (int _i = 0; _i < 2; ++_i) \
        __builtin_amdgcn_global_load_lds((const unsigned*)((const char*)(gbase) + (voff)[_i]), (PG8_LAS unsigned*)(lds + (bufoff) + ldsw + _i * 8192), 16, 0, 0); } while (0)
#define PG8_LDA(dst, b, h) do { _Pragma("unroll") for (int m = 0; m < 4; ++m) _Pragma("unroll") for (int k = 0; k < 2; ++k) dst[m][k] = *(const PG8_LAS bf16x8*)(lds + PG8_SA(b, h) + aoff + m * 2048 + k * 1024); } while (0)
#define PG8_LDB(dst, b, h) do { _Pragma("unroll") for (int n = 0; n < 2; ++n) _Pragma("unroll") for (int k = 0; k < 2; ++k) dst[n][k] = *(const PG8_LAS bf16x8*)(lds + PG8_SB(b, h) + boff + n * 2048 + k * 1024); } while (0)
#define PG8_MMA(ai, bj, At, Bt) do { __builtin_amdgcn_s_setprio(1); _Pragma("unroll") for (int m = 0; m < 4; ++m) _Pragma("unroll") for (int n = 0; n < 2; ++n) _Pragma("unroll") for (int k = 0; k < 2; ++k) \
        acc[ai][bj][m][n] = __builtin_amdgcn_mfma_f32_16x16x32_bf16(Bt[n][k], At[m][k], acc[ai][bj][m][n], 0, 0, 0); __builtin_amdgcn_s_setprio(0); } while (0)
#define PG8_WAIT_V(n) asm volatile("s_waitcnt vmcnt(" #n ")" ::: "memory")
#define PG8_WAIT_L(n) asm volatile("s_waitcnt lgkmcnt(" #n ")" ::: "memory")
#define PG8_BAR __builtin_amdgcn_s_barrier()
#define PG8_SCHED __builtin_amdgcn_sched_barrier(0)
    Unit cur, nxt; int ui = 0;
    if (!S.next(0, cur)) return;
    f32x4 acc[2][2][4][2];
#pragma unroll
    for (int a = 0; a < 2; ++a)
#pragma unroll
        for (int b = 0; b < 2; ++b)
#pragma unroll
            for (int m = 0; m < 4; ++m)
#pragma unroll
                for (int n = 0; n < 2; ++n) acc[a][b][m][n] = (f32x4){0.f, 0.f, 0.f, 0.f};
    bf16x8 At[4][2], B0[2][2], B1[2][2];
    const char* cA = (const char*)g.A + (size_t)cur.pm * tstep; const char* cB = (const char*)g.Bt + (size_t)cur.pn * tstep;
    S.a_ready(cur);
    if constexpr (SP2) {
        PG8_STAGE(PG8_SB(0, 0), cB, voffB); PG8_STAGE(PG8_SB(0, 1), cB + hstep, voffB); PG8_STAGE(PG8_SA(0, 0), cA, voffA); PG8_STAGE(PG8_SA(0, 1), cA + hstep, voffA);
        if (wr == 1) PG8_BAR;
        PG8_WAIT_V(2); PG8_BAR;
        PG8_STAGE(PG8_SB(1, 0), cB + kstep, voffB); PG8_STAGE(PG8_SA(1, 0), cA + kstep, voffA); PG8_STAGE(PG8_SB(1, 1), cB + hstep + kstep, voffB);
        PG8_WAIT_V(6); PG8_BAR;
    } else {
        PG8_STAGE(PG8_SB(0, 0), cB, voffB); PG8_STAGE(PG8_SA(0, 0), cA, voffA); PG8_STAGE(PG8_SB(0, 1), cB + hstep, voffB); PG8_STAGE(PG8_SA(0, 1), cA + hstep, voffA);
        if (wr == 1) PG8_BAR;
        PG8_WAIT_V(4); PG8_BAR;
        PG8_STAGE(PG8_SB(1, 0), cB + kstep, voffB); PG8_STAGE(PG8_SA(1, 0), cA + kstep, voffA); PG8_STAGE(PG8_SB(1, 1), cB + hstep + kstep, voffB);
        PG8_WAIT_V(6); PG8_BAR;
    }
    for (;;) {
        const bool has_next = S.next(ui + 1, nxt);
        const char* nA = has_next ? (const char*)g.A + (size_t)nxt.pm * tstep : cA; const char* nB = has_next ? (const char*)g.Bt + (size_t)nxt.pn * tstep : cB;
        for (int t = 0; t < nt; t += 2) {
            const bool last = (t == nt - 2);
            const char* a1 = cA + (size_t)(t + 1) * kstep;
            const char* a2 = last ? nA : cA + (size_t)(t + 2) * kstep; const char* b2 = last ? nB : cB + (size_t)(t + 2) * kstep;
            const char* a3 = a2 + kstep; const char* b3 = b2 + kstep;
            if (last && has_next) S.a_ready(nxt);
            if constexpr (SP2) {
            PG8_LDB(B0, 0, 0); PG8_LDB(B1, 0, 1); PG8_SCHED; PG8_LDA(At, 0, 0); PG8_STAGE(PG8_SA(1, 1), a1 + hstep, voffA);
            PG8_WAIT_V(8); PG8_WAIT_L(0); PG8_BAR; PG8_MMA(0, 0, At, B0); PG8_MMA(0, 1, At, B1); PG8_BAR; PG8_SCHED;
            PG8_LDA(At, 0, 1); PG8_STAGE(PG8_SB(0, 0), b2, voffB); PG8_STAGE(PG8_SB(0, 1), b2 + hstep, voffB); PG8_STAGE(PG8_SA(0, 0), a2, voffA);
            PG8_WAIT_V(8); PG8_WAIT_L(0); PG8_BAR; PG8_MMA(1, 0, At, B0); PG8_MMA(1, 1, At, B1); PG8_BAR; PG8_SCHED;
            PG8_LDB(B0, 1, 0); PG8_LDB(B1, 1, 1); PG8_SCHED; PG8_LDA(At, 1, 0); PG8_STAGE(PG8_SA(0, 1), a2 + hstep, voffA);
            PG8_WAIT_V(8); PG8_WAIT_L(0); PG8_BAR; PG8_MMA(0, 0, At, B0); PG8_MMA(0, 1, At, B1); PG8_BAR; PG8_SCHED;
            PG8_LDA(At, 1, 1); PG8_STAGE(PG8_SB(1, 0), b3, voffB); PG8_STAGE(PG8_SB(1, 1), b3 + hstep, voffB); PG8_STAGE(PG8_SA(1, 0), a3, voffA);
            PG8_WAIT_V(8); PG8_WAIT_L(0); PG8_BAR; PG8_MMA(1, 0, At, B0); PG8_MMA(1, 1, At, B1); PG8_BAR; PG8_SCHED;
            } else {
            PG8_LDB(B0, 0, 0); PG8_SCHED; PG8_LDA(At, 0, 0); PG8_STAGE(PG8_SA(1, 1), a1 + hstep, voffA);
            PG8_WAIT_L(8); PG8_BAR; PG8_WAIT_L(0); PG8_MMA(0, 0, At, B0); PG8_BAR; PG8_SCHED;
            PG8_LDB(B1, 0, 1); PG8_STAGE(PG8_SB(0, 0), b2, voffB);
            PG8_BAR; PG8_WAIT_L(0); PG8_MMA(0, 1, At, B1); PG8_BAR;
            PG8_LDA(At, 0, 1); PG8_STAGE(PG8_SA(0, 0), a2, voffA);
            PG8_BAR; PG8_WAIT_L(0); PG8_MMA(1, 0, At, B0); PG8_BAR; PG8_SCHED;
            PG8_STAGE(PG8_SB(0, 1), b2 + hstep, voffB);
            PG8_WAIT_V(6); PG8_BAR; PG8_MMA(1, 1, At, B1); PG8_BAR;
            PG8_LDB(B0, 1, 0); PG8_SCHED; PG8_LDA(At, 1, 0); PG8_STAGE(PG8_SA(0, 1), a2 + hstep, voffA);
            PG8_WAIT_L(8); PG8_BAR; PG8_WAIT_L(0); PG8_MMA(0, 0, At, B0); PG8_BAR; PG8_SCHED;
            PG8_LDB(B1, 1, 1); PG8_STAGE(PG8_SB(1, 0), b3, voffB);
            PG8_BAR; PG8_WAIT_L(0); PG8_MMA(0, 1, At, B1); PG8_BAR;
            PG8_LDA(At, 1, 1); PG8_STAGE(PG8_SA(1, 0), a3, voffA);
            PG8_BAR; PG8_WAIT_L(0); PG8_MMA(1, 0, At, B0); PG8_BAR; PG8_SCHED;
            PG8_STAGE(PG8_SB(1, 1), b3 + hstep, voffB);
            PG8_WAIT_V(6); PG8_BAR; PG8_MMA(1, 1, At, B1); PG8_BAR;
            }
        }
        if constexpr (ALIGN_EPI) { if (wr == 0) PG8_BAR; }
        if constexpr (!Epi::AFTER_DRAIN) { E(acc, cur, wr, wc, fr, fq); S.done(cur); }
        if (!has_next) break;
#pragma unroll
        for (int a = 0; a < 2; ++a)
#pragma unroll
            for (int b = 0; b < 2; ++b)
#pragma unroll
                for (int m = 0; m < 4; ++m)
#pragma unroll
                    for (int n = 0; n < 2; ++n) acc[a][b][m][n] = (f32x4){0.f, 0.f, 0.f, 0.f};
        cur = nxt; cA = nA; cB = nB; ++ui;
        if constexpr (ALIGN_EPI) { if (wr == 1) PG8_BAR; }
    }
    PG8_WAIT_V(0);
    if constexpr (!ALIGN_EPI) { if (wr == 0) PG8_BAR; }
    PG8_BAR;
    if constexpr (Epi::AFTER_DRAIN) { E.fused(acc, cur, wr, wc, fr, fq, lds, wid, lane); S.done(cur); }
#undef PG8_SA
#undef PG8_SB
#undef PG8_STAGE
#undef PG8_LDA
#undef PG8_LDB
#undef PG8_MMA
#undef PG8_WAIT_V
#undef PG8_WAIT_L
#undef PG8_BAR
#undef PG8_SCHED
}
}
namespace att {
using bf16 = __hip_bfloat16;
constexpr int   D = 128, NW = 8, QBLK = 32, KVBLK = 64;
constexpr float SCALE = 0.088388347648318440f;
constexpr float THR2 = 11.f;
constexpr float QSCALE = SCALE * 1.4426950408889634f;
constexpr int SDEPTH = 1;
constexpr int LDQ = 4608, LDK = 4608, LDO = 1024;
constexpr size_t SHM_V = KVBLK * D * 2, SHM_K = KVBLK * D * 2, SHM_ATTN = 2 * SHM_V + 2 * SHM_K + NW * 64 * 4;
using bf16x8 = __attribute__((ext_vector_type(8))) short;
using s16x4  = __attribute__((ext_vector_type(4))) short;
using f32x16 = __attribute__((ext_vector_type(16))) float;
using f32x8  = __attribute__((ext_vector_type(8))) float;
using u32x4  = __attribute__((ext_vector_type(4))) unsigned;
#define KSWZ(row, colB) ((row) * 256 + ((colB) ^ (((row) & 7) << 4)))
#define SBAR() __builtin_amdgcn_sched_barrier(0)
__device__ __forceinline__ int crow(int r, int hi) { return (r & 3) + 8 * (r >> 2) + 4 * hi; }
__device__ __forceinline__ unsigned cvtpk(float lo, float hi) {
  unsigned r; asm volatile("v_cvt_pk_bf16_f32 %0, %1, %2" : "=v"(r) : "v"(lo), "v"(hi)); return r;
}
template <typename TIn> struct Stage;
template <> struct Stage<bf16>  { using T = bf16x8;
  __device__ static __forceinline__ T ld8(const bf16* p) { return *reinterpret_cast<const bf16x8*>(p); }
  __device__ static __forceinline__ bf16x8 tobf(T x) { return x; } };
template <> struct Stage<float> { using T = f32x8;
  __device__ static __forceinline__ T ld8(const float* p) { return *reinterpret_cast<const f32x8*>(p); }
  __device__ static __forceinline__ bf16x8 tobf(T x) {
    u32x4 w = {cvtpk(x[0], x[1]), cvtpk(x[2], x[3]), cvtpk(x[4], x[5]), cvtpk(x[6], x[7])}; return *reinterpret_cast<bf16x8*>(&w); } };

__device__ __forceinline__ void partialSM(f32x16& p0) {
#pragma unroll
  for (int r = 0; r < 16; ++r) p0[r] = __builtin_amdgcn_exp2f(p0[r]);
}
__device__ __forceinline__ void finishSM(f32x16& p0, f32x16& p1, float& l_reg, bf16x8& pa0, bf16x8& pa1, bf16x8& pa2, bf16x8& pa3) {
  for (int r = 0; r < 16; ++r) p1[r] = __builtin_amdgcn_exp2f(p1[r]);
  float ps = 0; for (int r = 0; r < 16; ++r) ps += p0[r]; for (int r = 0; r < 16; ++r) ps += p1[r];
  { auto rr = __builtin_amdgcn_permlane32_swap(__float_as_uint(ps), __float_as_uint(ps), false, false);
    ps = __uint_as_float(rr[0]) + __uint_as_float(rr[1]); }
  l_reg += ps;
#define PK4(P, BASE, OUT) do { unsigned a0 = cvtpk(P[BASE + 0], P[BASE + 1]), a1 = cvtpk(P[BASE + 2], P[BASE + 3]);   \
    unsigned b0 = cvtpk(P[BASE + 4], P[BASE + 5]), b1 = cvtpk(P[BASE + 6], P[BASE + 7]);                              \
    auto r0 = __builtin_amdgcn_permlane32_swap(a0, b0, false, false); auto r1 = __builtin_amdgcn_permlane32_swap(a1, b1, false, false); \
    u32x4 w = {r0[0], r1[0], r0[1], r1[1]}; OUT = *reinterpret_cast<bf16x8*>(&w); } while (0)
  PK4(p0, 0, pa0); PK4(p0, 8, pa1); PK4(p1, 0, pa2); PK4(p1, 8, pa3);
#undef PK4
}
__device__ __forceinline__ void qkt(f32x16& p0, f32x16& p1, const bf16* Ks, const bf16x8* qr, const f32x16& negm, int r32, int hi) {
  const char* kb = (const char*)Ks + r32 * 32 + hi * 16;
#pragma unroll
  for (int d0 = 0; d0 < 8; ++d0) {
    bf16x8 b0 = *reinterpret_cast<const bf16x8*>(kb + d0 * 2048);
    bf16x8 b1 = *reinterpret_cast<const bf16x8*>(kb + d0 * 2048 + 1024);
    if (d0 == 0) { p0 = __builtin_amdgcn_mfma_f32_32x32x16_bf16(b0, qr[0], negm, 0, 0, 0); p1 = __builtin_amdgcn_mfma_f32_32x32x16_bf16(b1, qr[0], negm, 0, 0, 0); }
    else { p0 = __builtin_amdgcn_mfma_f32_32x32x16_bf16(b0, qr[d0], p0, 0, 0, 0); p1 = __builtin_amdgcn_mfma_f32_32x32x16_bf16(b1, qr[d0], p1, 0, 0, 0); } }
}
__device__ __forceinline__ int v_st(int k, int c) { const int kk = (k & ~0xC) | ((k & 4) << 1) | ((k & 8) >> 1); return ((kk >> 3) * 4 + (c >> 5)) * 512 + ((kk & 7) * 32 + (c & 31)) * 2; }
__device__ __forceinline__ int v_rd_base(int lane) { return ((lane & 3) << 3) | (((lane >> 2) & 3) << 6) | (((lane >> 4) & 1) << 5) | (((lane >> 5) & 1) << 8); }
constexpr int v_rd_off(int d0, int ks, int half) { return d0 * 512 + ks * 4096 + half * 2048; }
template <int OFF> __device__ __forceinline__ s16x4 tr_read(int vb) {
  s16x4 r; asm volatile("ds_read_b64_tr_b16 %0, %1 offset:%2" : "=&v"(r) : "v"(vb), "i"(OFF) : "memory"); return r;
}
template <int D0> __device__ __forceinline__ void pv_one(f32x16& od, int vb, bf16x8 pa0, bf16x8 pa1, bf16x8 pa2, bf16x8 pa3) {
  const s16x4 l0 = tr_read<v_rd_off(D0, 0, 0)>(vb), h0 = tr_read<v_rd_off(D0, 0, 1)>(vb), l1 = tr_read<v_rd_off(D0, 1, 0)>(vb), h1 = tr_read<v_rd_off(D0, 1, 1)>(vb);
  const s16x4 l2 = tr_read<v_rd_off(D0, 2, 0)>(vb), h2 = tr_read<v_rd_off(D0, 2, 1)>(vb), l3 = tr_read<v_rd_off(D0, 3, 0)>(vb), h3 = tr_read<v_rd_off(D0, 3, 1)>(vb);
  asm volatile("s_waitcnt lgkmcnt(0)" ::: "memory"); SBAR();
#define PK(L, H) (bf16x8){L[0], L[1], L[2], L[3], H[0], H[1], H[2], H[3]}
  od = __builtin_amdgcn_mfma_f32_32x32x16_bf16(pa0, PK(l0, h0), od, 0, 0, 0);
  od = __builtin_amdgcn_mfma_f32_32x32x16_bf16(pa1, PK(l1, h1), od, 0, 0, 0);
  od = __builtin_amdgcn_mfma_f32_32x32x16_bf16(pa2, PK(l2, h2), od, 0, 0, 0);
  od = __builtin_amdgcn_mfma_f32_32x32x16_bf16(pa3, PK(l3, h3), od, 0, 0, 0);
#undef PK
}
__device__ __forceinline__ void pv_d0(f32x16* o, int vb, bf16x8 pa0, bf16x8 pa1, bf16x8 pa2, bf16x8 pa3) {
  pv_one<0>(o[0], vb, pa0, pa1, pa2, pa3); pv_one<1>(o[1], vb, pa0, pa1, pa2, pa3); pv_one<2>(o[2], vb, pa0, pa1, pa2, pa3); pv_one<3>(o[3], vb, pa0, pa1, pa2, pa3);
}

template <typename TQ>
__device__ __forceinline__ void attn_dense_body(const TQ* __restrict__ Qb, const bf16* __restrict__ Kh, const bf16* __restrict__ Vh,
                                                float* __restrict__ Ob, int seq, char* lds, const float* __restrict__ qnw, const float* __restrict__ knw, const float* __restrict__ tab, int t0) {
  using SQ = Stage<TQ>;
  typedef __attribute__((address_space(3))) unsigned lds_u32;
  const int tid = threadIdx.x, lane = tid & 63, r32 = lane & 31, hi = lane >> 5;
  const int wid = __builtin_amdgcn_readfirstlane(tid >> 6);
  char* K_lds = lds; char* V_lds = lds + 3 * SHM_K;
  float* ws = (float*)(lds + 3 * SHM_V + 3 * SHM_K) + wid * 64; float* li_l = ws; float* al_l = ws + 32;
  float l_reg = 0; f32x16 o[4] = {}; bf16x8 qr[8]; f32x16 negm = {}; asm volatile("" : "+v"(negm));
  const TQ* Qw = Qb + (long)(wid * QBLK + r32) * LDQ + hi * 8;
  {
    const int t = t0 + wid * QBLK + r32; float x[8][8]; float ss = 0.f;
#pragma unroll
    for (int d0 = 0; d0 < 8; ++d0) { const u32x4 raw = *reinterpret_cast<const u32x4*>(Qw + d0 * 16);
#pragma unroll
      for (int k = 0; k < 4; ++k) { x[d0][2 * k] = __uint_as_float(raw[k] << 16); x[d0][2 * k + 1] = __uint_as_float(raw[k] & 0xffff0000u); ss += x[d0][2 * k] * x[d0][2 * k] + x[d0][2 * k + 1] * x[d0][2 * k + 1]; } }
    { auto rr = __builtin_amdgcn_permlane32_swap(__float_as_uint(ss), __float_as_uint(ss), false, false); ss = __uint_as_float(rr[0]) + __uint_as_float(rr[1]); }
    const float rstd = rsqrtf(ss * (1.f / 128.f) + 1e-6f); float n2 = 0.f;
#pragma unroll
    for (int d0 = 0; d0 < 8; ++d0) { const float* wp = qnw + d0 * 16 + hi * 8;
#pragma unroll
      for (int e = 0; e < 8; ++e) { x[d0][e] *= rstd * wp[e]; n2 += x[d0][e] * x[d0][e]; } }
    { auto rr = __builtin_amdgcn_permlane32_swap(__float_as_uint(n2), __float_as_uint(n2), false, false); n2 = __uint_as_float(rr[0]) + __uint_as_float(rr[1]); }
    float kwm = fmaxf(fabsf(knw[2 * lane]), fabsf(knw[2 * lane + 1]));
#pragma unroll
    for (int o_ = 1; o_ < 64; o_ <<= 1) kwm = fmaxf(kwm, __shfl_xor(kwm, o_));
    const float mref = fminf(sqrtf(n2) * QSCALE * 11.313708499f * kwm * 1.0005f, 60.f);
#pragma unroll
    for (int r = 0; r < 16; ++r) negm[r] = -mref;
    asm volatile("" : "+v"(negm));
#pragma unroll
    for (int half = 0; half < 2; ++half) { const int pos = half ? (t & 63) : (t >> 6);
#pragma unroll
      for (int b = 0; b < 2; ++b) { const float* tp = tab + (pos * 32 + b * 16 + hi * 8) * 2;
#pragma unroll
        for (int e = 0; e < 8; ++e) { const float c = tp[2 * e], sn = tp[2 * e + 1]; const float x1 = x[half * 4 + b][e], x2 = x[half * 4 + b + 2][e];
          x[half * 4 + b][e] = (x1 * c - x2 * sn) * QSCALE; x[half * 4 + b + 2][e] = (x2 * c + x1 * sn) * QSCALE; } } }
#pragma unroll
    for (int d0 = 0; d0 < 8; ++d0) { u32x4 w = {cvtpk(x[d0][0], x[d0][1]), cvtpk(x[d0][2], x[d0][3]), cvtpk(x[d0][4], x[d0][5]), cvtpk(x[d0][6], x[d0][7])}; qr[d0] = *reinterpret_cast<bf16x8*>(&w); }
  }
  const int vb0 = (int)(uintptr_t)V_lds + v_rd_base(lane);
  unsigned koff, voff;
  { const int d0 = wid >> 1, row = (wid & 1) * 32 + (lane >> 1), h_ = lane & 1; koff = (unsigned)(row * LDK + d0 * 16 + h_ * 8) * 2u; }
  { const int sub = wid * 2 + (lane >> 5), kk = (sub >> 2) * 8 + ((lane & 31) >> 2), c = (sub & 3) * 32 + (lane & 3) * 8;
    const int k = (kk & ~0xC) | ((kk & 4) << 1) | ((kk & 8) >> 1); voff = (unsigned)(k * LDK + c) * 2u; }
  const __attribute__((address_space(3))) char* kdst = (const __attribute__((address_space(3))) char*)(unsigned)(uintptr_t)(K_lds + wid * 1024);
  const __attribute__((address_space(3))) char* vdst = (const __attribute__((address_space(3))) char*)(unsigned)(uintptr_t)(V_lds + wid * 1024);
#define DMA(k0, off) do { const char* kt_ = (const char*)Kh + (size_t)(k0) * (LDK * 2); const char* vt_ = (const char*)Vh + (size_t)(k0) * (LDK * 2); \
      __builtin_amdgcn_global_load_lds((const unsigned*)(kt_ + koff), (lds_u32*)(kdst + (off)), 16, 0, 0); \
      __builtin_amdgcn_global_load_lds((const unsigned*)(kt_ + 128 + koff), (lds_u32*)(kdst + (off) + 8192), 16, 0, 0); \
      __builtin_amdgcn_global_load_lds((const unsigned*)(vt_ + voff), (lds_u32*)(vdst + (off)), 16, 0, 0); \
      __builtin_amdgcn_global_load_lds((const unsigned*)(vt_ + 32 * LDK * 2 + voff), (lds_u32*)(vdst + (off) + 8192), 16, 0, 0); } while (0)
#define VWAIT() asm volatile("s_waitcnt vmcnt(0)" ::: "memory")
#define ROT() do { sl_prev = sl_cur; sl_cur = sl_next; sl_next = (sl_next == 2 * (int)SHM_K) ? 0 : sl_next + (int)SHM_K; } while (0)
  f32x16 pA0, pA1, pB0, pB1; bf16x8 pa0, pa1, pa2, pa3; const int NT = seq / KVBLK;
  DMA(0, 0); DMA(KVBLK, (int)SHM_K); VWAIT(); __syncthreads();
  qkt(pA0, pA1, (const bf16*)K_lds, qr, negm, r32, hi); partialSM(pA0);
  int sl_prev = 0, sl_cur = (int)SHM_K, sl_next = 2 * (int)SHM_K;
#define STEP(PC0, PC1, PP0, PP1, LD, jn1) do { \
    if (LD) { DMA((jn1) * KVBLK, sl_next); } SBAR(); \
    qkt(PC0, PC1, (const bf16*)(K_lds + sl_cur), qr, negm, r32, hi); \
    finishSM(PP0, PP1, l_reg, pa0, pa1, pa2, pa3); SBAR(); \
    pv_d0(o, vb0 + sl_prev, pa0, pa1, pa2, pa3); partialSM(PC0); \
    VWAIT(); __syncthreads(); ROT(); } while (0)
  int j = 1;
  for (; j + 2 < NT; j += 2) {
    STEP(pB0, pB1, pA0, pA1, true, j + 1);
    STEP(pA0, pA1, pB0, pB1, true, j + 2);
  }
  STEP(pB0, pB1, pA0, pA1, false, 0);
  finishSM(pB0, pB1, l_reg, pa0, pa1, pa2, pa3); SBAR();
  pv_d0(o, vb0 + sl_prev, pa0, pa1, pa2, pa3);
  if (hi == 0) li_l[r32] = l_reg; asm volatile("s_waitcnt lgkmcnt(0)" ::: "memory");
  float rli[16];
#pragma unroll
  for (int r = 0; r < 16; ++r) rli[r] = __builtin_amdgcn_rcpf(li_l[crow(r, hi)]);
  float* Ow = Ob + (long)(wid * QBLK) * LDO;
#pragma unroll
  for (int r = 0; r < 16; ++r) { int orow = crow(r, hi);
    for (int d0 = 0; d0 < 4; ++d0) Ow[(long)orow * LDO + d0 * 32 + r32] = o[d0][r] * rli[r]; }
#undef DMA
#undef VWAIT
#undef ROT
#undef STEP
}
#undef KSWZ
#undef SBAR
}
constexpr int M = 16384, DM = 2048, NIN = 4608, AW = 1024, LW = 1024, MIXW = 2048;
constexpr int C_Q = 0, C_K = 1024, C_V = 1280, C_GA = 1536, C_XR = 2560, C_GL = 3584;
constexpr float EPS = 1e-6f;
constexpr int NTHREADS = 512, NWAVES = 8;
constexpr int LDS_BYTES = 131072;
constexpr size_t MiB = 1u << 20;
constexpr size_t WS_WIN = 2 * MiB;
constexpr size_t WS_WOUT = 20 * MiB;
constexpr size_t WS_WG = 28 * MiB;
constexpr size_t WS_TAB = 29 * MiB;
constexpr size_t WS_CARRY = 31 * MiB;
constexpr size_t WS_SUMM = 30 * MiB;
constexpr size_t WS_XN = 32 * MiB;
constexpr size_t WS_PROJ = 96 * MiB;
constexpr size_t WS_O = 240 * MiB;
constexpr size_t WS_HF = 304 * MiB;
constexpr size_t WS_HB = 368 * MiB;
constexpr size_t WS_END = 432 * MiB;

#define LAS __attribute__((address_space(3)))
typedef unsigned short bf16r;
typedef float f32x4 __attribute__((ext_vector_type(4)));
typedef float f32x2 __attribute__((ext_vector_type(2)));
typedef float f32x16 __attribute__((ext_vector_type(16)));
typedef unsigned u32x4 __attribute__((ext_vector_type(4)));
typedef unsigned u32x2 __attribute__((ext_vector_type(2)));
typedef short bf16x8 __attribute__((ext_vector_type(8)));

__device__ __forceinline__ unsigned pk2(float lo, float hi) { unsigned r; asm volatile("v_cvt_pk_bf16_f32 %0, %1, %2" : "=v"(r) : "v"(lo), "v"(hi)); return r; }
__device__ __forceinline__ float bflo(unsigned v) { return __uint_as_float(v << 16); }
__device__ __forceinline__ float bfhi(unsigned v) { return __uint_as_float(v & 0xffff0000u); }
__device__ __forceinline__ float wave_sum(float v) {
#pragma unroll
    for (int o = 1; o < 64; o <<= 1) v += __shfl_xor(v, o);
    return v;
}
__device__ __forceinline__ float sigmoidf_(float z) { return __builtin_amdgcn_rcpf(1.f + __expf(-z)); }

struct Args { const float* in[15]; float* out; unsigned char* ws; int ph_lo, ph_hi; };
enum { I_X = 0, I_NORMW, I_WIN, I_QNW, I_KNW, I_CONVW, I_CONVB, I_WA, I_BA, I_WX, I_BX, I_LAM, I_ANW, I_LNW, I_WOUT };

__device__ __forceinline__ void transpose_item(const float* W, int ldw, int nblk, bf16r* WT, int ldo, LAS float* scr, int item, int lane) {
    const int kb = item / nblk, nb = item % nblk, k0 = 64 * kb, n0 = 32 * nb;
#pragma unroll 8
    for (int i = 0; i < 32; ++i) { const int kk = 2 * i + (lane >> 5); scr[kk * 33 + (lane & 31)] = W[(size_t)(k0 + kk) * ldw + n0 + (lane & 31)]; }
    asm volatile("s_waitcnt lgkmcnt(0)" ::: "memory");
    const int c = lane & 7;
#pragma unroll
    for (int j = 0; j < 4; ++j) { const int n = (lane >> 3) + 8 * j; const LAS float* s = scr + (8 * c) * 33 + n;
        u32x4 o; o.x = pk2(s[0 * 33], s[1 * 33]); o.y = pk2(s[2 * 33], s[3 * 33]); o.z = pk2(s[4 * 33], s[5 * 33]); o.w = pk2(s[6 * 33], s[7 * 33]);
        *(u32x4*)(WT + (size_t)(n0 + n) * ldo + k0 + 8 * c) = o; }
    asm volatile("s_waitcnt lgkmcnt(0)" ::: "memory");
}
__device__ __forceinline__ void p0_prologue(const Args& a, LAS unsigned char* lds, int gw, int NGW, int lane, int wave) {
    unsigned char* ws = a.ws;
    LAS float* scr = (LAS float*)(lds + wave * 16384);
    constexpr int I_IN = (DM / 64) * (NIN / 32), I_OUT = (MIXW / 64) * (DM / 32), I_G = 32 * 8;
    for (int it = gw; it < I_IN + I_OUT + I_G; it += NGW) {
        if (it < I_IN) transpose_item(a.in[I_WIN], NIN, NIN / 32, (bf16r*)(ws + WS_WIN), DM, scr, it, lane);
        else if (it < I_IN + I_OUT) transpose_item(a.in[I_WOUT], DM, DM / 32, (bf16r*)(ws + WS_WOUT), MIXW, scr, it - I_IN, lane);
        else { const int r = it - I_IN - I_OUT, mat = r >> 3, sub = r & 7, which = mat >> 4, db = mat & 15;
            const float* src = (which ? a.in[I_WX] : a.in[I_WA]) + (size_t)db * 128 * 128;
            bf16r* dst = (bf16r*)(ws + WS_WG) + (size_t)db * 256 * 128 + (size_t)which * 128 * 128;
            transpose_item(src, 128, 4, dst, 128, scr, sub, lane); }
    }
    { const int e = gw * 64 + lane;
      if (e < 256 * 32) { const int pos = e >> 5, i = e & 31;
        const float invf = __builtin_amdgcn_exp2f(-(float)i * 0.41524101186092029f);
        const float ang = (float)pos * invf;
        const double ad = (double)ang; const double k = __builtin_rint(ad * 0.63661977236758134);
        const double r = __builtin_fma(-k, 1.5707963267948966, ad); const double r2 = r * r;
        const double sn = r * (1.0 + r2 * (-1.0 / 6 + r2 * (1.0 / 120 + r2 * (-1.0 / 5040 + r2 * (1.0 / 362880 + r2 * (-1.0 / 39916800))))));
        const double cs = 1.0 + r2 * (-0.5 + r2 * (1.0 / 24 + r2 * (-1.0 / 720 + r2 * (1.0 / 40320 + r2 * (-1.0 / 3628800 + r2 * (1.0 / 479001600))))));
        const int q = ((int)k) & 3;
        const double c_ = (q == 0) ? cs : (q == 1) ? -sn : (q == 2) ? -cs : sn;
        const double s_ = (q == 0) ? sn : (q == 1) ? cs : (q == 2) ? -sn : -cs;
        f32x2 o; o.x = (float)c_; o.y = (float)s_; ((f32x2*)(ws + WS_TAB))[e] = o; } }
    const float* x = a.in[I_X]; const f32x4* nw = (const f32x4*)a.in[I_NORMW] + lane;
    for (int m = gw; m < M; m += NGW) {
        const f32x4* xr = (const f32x4*)(x + (size_t)m * DM) + lane; f32x4 v[8]; float s = 0.f;
#pragma unroll
        for (int j = 0; j < 8; ++j) { v[j] = xr[64 * j]; s += (v[j].x * v[j].x + v[j].y * v[j].y) + (v[j].z * v[j].z + v[j].w * v[j].w); }
        const float rstd = rsqrtf(wave_sum(s) * (1.f / DM) + EPS);
        u32x2* o8 = (u32x2*)((bf16r*)(ws + WS_XN) + (size_t)m * DM) + lane;
#pragma unroll
        for (int j = 0; j < 8; ++j) { const f32x4 w = nw[64 * j]; u32x2 o; o.x = pk2(v[j].x * rstd * w.x, v[j].y * rstd * w.y); o.y = pk2(v[j].z * rstd * w.z, v[j].w * rstd * w.w); o8[64 * j] = o; }
    }
}

__device__ __forceinline__ void p2_qkprep(const Args& a, int gw, int NGW, int lane) {
    bf16r* proj = (bf16r*)(a.ws + WS_PROJ); const float* tab = (const float*)(a.ws + WS_TAB);
    const f32x2 kw = ((const f32x2*)a.in[I_KNW])[lane];
    const int i0 = (2 * lane) & 31; const float sgn = (lane & 16) ? 1.f : -1.f;
    for (int t0 = gw; t0 < M; t0 += 4 * NGW) {
        unsigned v[4][2]; f32x4 cs[4]; unsigned* rowp[4];
#pragma unroll
        for (int q = 0; q < 4; ++q) { const int t = min(t0 + q * NGW, M - 1); const int pos = (lane < 32) ? (t >> 6) : (t & 63);
            cs[q] = *(const f32x4*)(tab + (pos * 32 + i0) * 2);
            rowp[q] = (unsigned*)(proj + (size_t)t * NIN + C_K) + lane; v[q][0] = rowp[q][0]; v[q][1] = rowp[q][64]; }
#pragma unroll
        for (int q = 0; q < 4; ++q) { if (t0 + q * NGW >= M) break;
#pragma unroll
            for (int hh = 0; hh < 2; ++hh) {
                const float x0 = bflo(v[q][hh]), x1 = bfhi(v[q][hh]);
                const float rstd = rsqrtf(wave_sum(x0 * x0 + x1 * x1) * (1.f / 128.f) + EPS);
                const float y0 = x0 * rstd * kw.x, y1 = x1 * rstd * kw.y;
                const float p0 = __shfl_xor(y0, 16), p1 = __shfl_xor(y1, 16);
                rowp[q][hh * 64] = pk2(y0 * cs[q].x + sgn * p0 * cs[q].y, y1 * cs[q].z + sgn * p1 * cs[q].w); } }
    }
}

constexpr int L_SUM = 0, L_CW = 8192, L_WT = 16384;
#define KSWZ_(row, colB) ((row) * 256 + ((colB) ^ (((row) & 7) << 4)))
__device__ __forceinline__ int crow_(int r, int hi) { return (r & 3) + 8 * (r >> 2) + 4 * hi; }
template <int DIR>
__device__ __forceinline__ void lru_unit(const Args& a, LAS unsigned char* lds, int ck, int blk, bool load_w) {
    int tid = threadIdx.x; asm volatile("" : "+v"(tid));
    const int lane = tid & 63, r32 = lane & 31, hi = lane >> 5;
    const int w = __builtin_amdgcn_readfirstlane(tid >> 6);
    constexpr int d = DIR;
    unsigned char* ws = a.ws;
    const bf16r* proj = (const bf16r*)(ws + WS_PROJ);
    LAS float* CWl = (LAS float*)(lds + L_CW);
    LAS f32x2* SUM = (LAS f32x2*)(lds + L_SUM);
    __syncthreads();
    if (load_w) {
        const bf16r* Wt = (const bf16r*)(ws + WS_WG) + (size_t)(d * 8 + blk) * 256 * 128;
#pragma unroll
        for (int i = 0; i < 8; ++i) { const int p = tid + 512 * i, row = p >> 4, c16 = p & 15;
            const u32x4 v = *(const u32x4*)(Wt + row * 128 + c16 * 8); *(LAS u32x4*)(lds + L_WT + KSWZ_(row, c16 * 16)) = v; }
        const float* cw = a.in[I_CONVW]; const float* cbias = a.in[I_CONVB];
        for (int e = tid; e < 640; e += 512) CWl[e] = e < 512 ? cw[(e >> 7) * 1024 + blk * 128 + (e & 127)] : cbias[blk * 128 + (e - 512)];
    }
    __syncthreads();
    const int t = ck * 256 + w * 32 + r32;
    bf16x8 A[8];
#pragma unroll
    for (int kk = 0; kk < 8; ++kk) { const int c0 = kk * 16 + hi * 8;
        f32x4 acc0 = *(const LAS f32x4*)(CWl + 512 + c0), acc1 = *(const LAS f32x4*)(CWl + 512 + c0 + 4);
#pragma unroll
        for (int j = 0; j < 4; ++j) { const int tt = t + j - 2; const bool ok = tt >= 0 && tt < M; const int tc = ok ? tt : t;
            u32x4 xv = *(const u32x4*)(proj + (size_t)tc * NIN + C_XR + blk * 128 + c0);
            if (!ok) xv = (u32x4){0u, 0u, 0u, 0u};
            const f32x4 w0 = *(const LAS f32x4*)(CWl + j * 128 + c0), w1 = *(const LAS f32x4*)(CWl + j * 128 + c0 + 4);
            acc0.x += w0.x * bflo(xv.x); acc0.y += w0.y * bfhi(xv.x); acc0.z += w0.z * bflo(xv.y); acc0.w += w0.w * bfhi(xv.y);
            acc1.x += w1.x * bflo(xv.z); acc1.y += w1.y * bfhi(xv.z); acc1.z += w1.z * bflo(xv.w); acc1.w += w1.w * bfhi(xv.w); }
        u32x4 o; o.x = pk2(acc0.x, acc0.y); o.y = pk2(acc0.z, acc0.w); o.z = pk2(acc1.x, acc1.y); o.w = pk2(acc1.z, acc1.w);
        A[kk] = __builtin_bit_cast(bf16x8, o); if ((kk & 3) == 3) asm volatile("" ::: "memory"); }
    bf16x8 Bid[2];
#pragma unroll
    for (int kq = 0; kq < 2; ++kq)
#pragma unroll
        for (int j = 0; j < 8; ++j) Bid[kq][j] = (16 * kq + 8 * hi + j == r32) ? (short)0x3F80 : (short)0;
    unsigned* hcout = (unsigned*)(ws + (d ? WS_HB : WS_HF));
#pragma unroll
    for (int rd = 0; rd < 4; ++rd) {
        float hl[1][16], cq[1][16];
#pragma unroll
        for (int cc = 0; cc < 1; ++cc) { const int ct = rd + cc;
            f32x16 accr = {}, acci = {}, accx = {};
#pragma unroll
            for (int kk = 0; kk < 8; ++kk) {
                const bf16x8 br = *(const LAS bf16x8*)(lds + L_WT + KSWZ_(ct * 32 + r32, (kk * 16 + hi * 8) * 2));
                const bf16x8 bi = *(const LAS bf16x8*)(lds + L_WT + KSWZ_(128 + ct * 32 + r32, (kk * 16 + hi * 8) * 2));
                accr = __builtin_amdgcn_mfma_f32_32x32x16_bf16(A[kk], br, accr, 0, 0, 0);
                acci = __builtin_amdgcn_mfma_f32_32x32x16_bf16(A[kk], bi, acci, 0, 0, 0);
            }
            accx = __builtin_amdgcn_mfma_f32_32x32x16_bf16(A[2 * ct], Bid[0], accx, 0, 0, 0);
            accx = __builtin_amdgcn_mfma_f32_32x32x16_bf16(A[2 * ct + 1], Bid[1], accx, 0, 0, 0);
            const int cidx = d * 1024 + blk * 128 + ct * 32 + r32;
            const float ba = a.in[I_BA][cidx], bx = a.in[I_BX][cidx], lam = a.in[I_LAM][cidx];
            const float sp8 = 8.f * log1pf(__expf(-lam));
            float av[16], bv[16];
#pragma unroll
            for (int r = 0; r < 16; ++r) {
                const float rg = __builtin_amdgcn_rcpf(1.f + __builtin_amdgcn_exp2f(-1.4426950408889634f * (accr[r] + ba)));
                const float ig = __builtin_amdgcn_rcpf(1.f + __builtin_amdgcn_exp2f(-1.4426950408889634f * (acci[r] + bx)));
                const float la = -sp8 * rg; const float aa = __builtin_amdgcn_exp2f(1.4426950408889634f * la);
                const float om = __builtin_fmaf(-aa, aa, 1.f);
                av[r] = aa; bv[r] = __builtin_amdgcn_sqrtf(om) * ig * accx[r];
            }
            float Pg[4], Hg[4];
#pragma unroll
            for (int g = 0; g < 4; ++g) { float h = 0.f, cp = 1.f;
#pragma unroll
                for (int e = 0; e < 4; ++e) { const int r = 4 * g + (DIR == 0 ? e : 3 - e); h = av[r] * h + bv[r]; cp *= av[r]; bv[r] = h; av[r] = cp; }
                Pg[g] = cp; Hg[g] = h; }
            float F = 1.f, E = 0.f, Fg[4], Eg[4];
#pragma unroll
            for (int gi = 0; gi < 4; ++gi) { const int g = DIR == 0 ? gi : 3 - gi;
                const float pP = __shfl_xor(Pg[g], 32), pH = __shfl_xor(Hg[g], 32);
                const float Pe = hi ? pP : Pg[g], He = hi ? pH : Hg[g];
                const float Po = hi ? Pg[g] : pP, Ho = hi ? Hg[g] : pH;
                if (DIR == 0) { const float F1 = Pe * F, E1 = Pe * E + He; Fg[g] = hi ? F1 : F; Eg[g] = hi ? E1 : E; F = Po * F1; E = Po * E1 + Ho; }
                else          { const float F1 = Po * F, E1 = Po * E + Ho; Fg[g] = hi ? F : F1; Eg[g] = hi ? E : E1; F = Pe * F1; E = Pe * E1 + He; } }
            if (hi == 0) { f32x2 o; o.x = F; o.y = E; SUM[(rd * 8 + w) * 32 + r32] = o; }
#pragma unroll
            for (int r = 0; r < 16; ++r) { hl[cc][r] = bv[r] + av[r] * Eg[r >> 2]; cq[cc][r] = av[r] * Fg[r >> 2]; }
        }
        __syncthreads();
        {
            const int ct = rd; float Fw = 1.f, Ew = 0.f;
            if (DIR == 0) { for (int wp = 0; wp < w; ++wp) { const f32x2 fe = SUM[(rd * 8 + wp) * 32 + r32]; Ew = fe.x * Ew + fe.y; Fw *= fe.x; } }
            else          { for (int wp = 7; wp > w; --wp) { const f32x2 fe = SUM[(rd * 8 + wp) * 32 + r32]; Ew = fe.x * Ew + fe.y; Fw *= fe.x; } }
            const size_t o0 = (size_t)(ck * 256 + w * 32) * LW + blk * 128 + ct * 32 + r32;
#pragma unroll
            for (int r = 0; r < 16; ++r) { const size_t oo = o0 + (size_t)crow_(r, hi) * LW;
                hcout[oo] = pk2(hl[0][r] + cq[0][r] * Ew, cq[0][r] * Fw); }
        }
        if (tid < 32) {
            float F = 1.f, E = 0.f;
#pragma unroll
            for (int wi = 0; wi < 8; ++wi) { const int wp = DIR == 0 ? wi : 7 - wi; const f32x2 fe = SUM[(rd * 8 + wp) * 32 + tid]; E = fe.x * E + fe.y; F *= fe.x; }
            f32x2 o; o.x = F; o.y = E; ((f32x2*)(ws + WS_SUMM))[(ck * 2 + d) * 1024 + blk * 128 + rd * 32 + tid] = o;
        }
    }
}
__device__ __forceinline__ void lru_phase(const Args& a, LAS unsigned char* lds, int bid, int G, int nrep) {
    const int key = bid & 15, d = key & 1, blk = key >> 1, ck0 = bid >> 4, dck = G >> 4;
    if (d == 0) { bool first = true; for (int c_ = ck0; c_ < 64 * nrep; c_ += dck) { lru_unit<0>(a, lds, c_ & 63, blk, first); first = false; } }
    else        { bool first = true; for (int c_ = ck0; c_ < 64 * nrep; c_ += dck) { lru_unit<1>(a, lds, c_ & 63, blk, first); first = false; } }
    __syncthreads();
}
__device__ __forceinline__ void carry_phase(const Args& a, int gw, int NGW, int lane) {
    const f32x2* summ = (const f32x2*)(a.ws + WS_SUMM); float* carry = (float*)(a.ws + WS_CARRY);
    for (int ch = gw; ch < 2048; ch += NGW) { const int d = ch >> 10, c = ch & 1023, kk = d ? 63 - lane : lane;
        const f32x2 s = summ[(kk * 2 + d) * 1024 + c]; float P = s.x, H = s.y;
#pragma unroll
        for (int off = 1; off < 64; off <<= 1) { const float Pp = __shfl_up(P, off), Hp = __shfl_up(H, off); if (lane >= off) { H = P * Hp + H; P = P * Pp; } }
        const float cin = __shfl_up(H, 1);
        carry[(kk * 2 + d) * 1024 + c] = lane ? cin : 0.f; }
}

__device__ __forceinline__ void p4_mix(const Args& a, int gw, int NGW, int lane) {
    unsigned char* ws = a.ws;
    const bf16r* proj = (const bf16r*)(ws + WS_PROJ); bf16r* mixed = (bf16r*)(ws + WS_XN);
    const float* O = (const float*)(ws + WS_O);
    const unsigned* HCF = (const unsigned*)(ws + WS_HF); const unsigned* HCB = (const unsigned*)(ws + WS_HB);
    const float* carry = (const float*)(ws + WS_CARRY);
    const f32x4* anw = (const f32x4*)a.in[I_ANW] + lane; const f32x4* lnw = (const f32x4*)a.in[I_LNW] + lane;
    for (int b8 = gw; b8 < M / 8; b8 += NGW) {
        const int ck = b8 >> 5; f32x4 cf[4], cb[4];
#pragma unroll
        for (int j = 0; j < 4; ++j) { cf[j] = ((const f32x4*)(carry + (ck * 2 + 0) * 1024) + lane)[64 * j]; cb[j] = ((const f32x4*)(carry + (ck * 2 + 1) * 1024) + lane)[64 * j]; }
        for (int rr = 0; rr < 8; ++rr) { const int m = b8 * 8 + rr;
        f32x4 v[4], u[4]; float s1 = 0.f, s2 = 0.f;
#pragma unroll
        for (int j = 0; j < 4; ++j) {
            v[j] = ((const f32x4*)(O + (size_t)m * AW) + lane)[64 * j];
            const u32x4 f = ((const u32x4*)(HCF + (size_t)m * LW) + lane)[64 * j], b = ((const u32x4*)(HCB + (size_t)m * LW) + lane)[64 * j];
            u[j].x = (bflo(f.x) + bfhi(f.x) * cf[j].x) + (bflo(b.x) + bfhi(b.x) * cb[j].x);
            u[j].y = (bflo(f.y) + bfhi(f.y) * cf[j].y) + (bflo(b.y) + bfhi(b.y) * cb[j].y);
            u[j].z = (bflo(f.z) + bfhi(f.z) * cf[j].z) + (bflo(b.z) + bfhi(b.z) * cb[j].z);
            u[j].w = (bflo(f.w) + bfhi(f.w) * cf[j].w) + (bflo(b.w) + bfhi(b.w) * cb[j].w);
            s1 += (v[j].x * v[j].x + v[j].y * v[j].y) + (v[j].z * v[j].z + v[j].w * v[j].w);
            s2 += (u[j].x * u[j].x + u[j].y * u[j].y) + (u[j].z * u[j].z + u[j].w * u[j].w); }
        const float r1 = rsqrtf(wave_sum(s1) * (1.f / AW) + EPS), r2 = rsqrtf(wave_sum(s2) * (1.f / LW) + EPS);
        const u32x2* ga = (const u32x2*)(proj + (size_t)m * NIN + C_GA) + lane; const u32x2* gl = (const u32x2*)(proj + (size_t)m * NIN + C_GL) + lane;
        u32x2* mo = (u32x2*)(mixed + (size_t)m * MIXW) + lane;
#pragma unroll
        for (int j = 0; j < 4; ++j) {
            { const u32x2 g = ga[64 * j]; const f32x4 w = anw[64 * j];
              const float g0 = bflo(g.x), g1 = bfhi(g.x), g2 = bflo(g.y), g3 = bfhi(g.y);
              u32x2 o; o.x = pk2(v[j].x * r1 * w.x * g0 * sigmoidf_(g0), v[j].y * r1 * w.y * g1 * sigmoidf_(g1));
              o.y = pk2(v[j].z * r1 * w.z * g2 * sigmoidf_(g2), v[j].w * r1 * w.w * g3 * sigmoidf_(g3)); mo[64 * j] = o; }
            { const u32x2 g = gl[64 * j]; const f32x4 w = lnw[64 * j];
              const float g0 = bflo(g.x), g1 = bfhi(g.x), g2 = bflo(g.y), g3 = bfhi(g.y);
              u32x2 o; o.x = pk2(u[j].x * r2 * w.x * g0 * sigmoidf_(g0), u[j].y * r2 * w.y * g1 * sigmoidf_(g1));
              o.y = pk2(u[j].z * r2 * w.z * g2 * sigmoidf_(g2), u[j].w * r2 * w.w * g3 * sigmoidf_(g3)); mo[256 + 64 * j] = o; }
        }
        }
    }
}

#define RLX_AGENT __ATOMIC_RELAXED, __HIP_MEMORY_SCOPE_AGENT
#define XB_TMO      128
#define XB_XCNT(j)  (256  + 64 * (j))
#define XB_XSUB(j)  (1280 + 64 * (j))
#define XB_XGEN(j)  (2304 + 64 * (j))
#define XB_TOP      3328
#define XB_TOPGEN   3392
#define XCD_BAR_WORDS 3456
#define XB_SPIN_CAP (1u << 18)

__device__ __forceinline__ unsigned xb_ld(unsigned* p)              { return __hip_atomic_load(p, __ATOMIC_RELAXED, __HIP_MEMORY_SCOPE_AGENT); }
__device__ __forceinline__ unsigned xb_add(unsigned* p, unsigned v) { return __hip_atomic_fetch_add(p, v, __ATOMIC_RELAXED, __HIP_MEMORY_SCOPE_AGENT); }
__device__ __forceinline__ unsigned xb_xcc_id() { return (unsigned)__builtin_amdgcn_s_getreg((3 << 11) | 20) & 0xFu; }
#define XB_SPIN(cond, bar) do { unsigned _sp = 0; while (cond) { __builtin_amdgcn_s_sleep(1); \
    if ((++_sp & 255u) == 0u) { if (xb_ld(&(bar)[XB_TMO])) break; if (_sp > XB_SPIN_CAP) { atomicAdd(&(bar)[XB_TMO], 1u); break; } } } } while (0)

struct XcdBarrier {
    unsigned* bar; unsigned x;
    volatile LAS unsigned* st;
};

__device__ __forceinline__ XcdBarrier xcd_barrier_post(unsigned* bar, volatile LAS unsigned* st) {
    XcdBarrier b; b.bar = bar; b.x = xb_xcc_id(); b.st = st;
    if (threadIdx.x == 0) (void)xb_add(&bar[XB_XCNT(b.x)], 1u);
    return b;
}
__device__ __forceinline__ void xcd_barrier_complete(unsigned* bar, unsigned x, unsigned& nloc, unsigned& nx) {
    const unsigned G = gridDim.x * gridDim.y * gridDim.z;
    unsigned sum, cnt, mine, sp = 0u;
    for (;;) {
        sum = 0u; cnt = 0u; mine = 0u;
#pragma unroll
        for (unsigned j = 0; j < 16; ++j) { const unsigned c = xb_ld(&bar[XB_XCNT(j)]); sum += c; cnt += (c > 0u) ? 1u : 0u; mine = (j == x) ? c : mine; }
        if (sum == G) break;
        __builtin_amdgcn_s_sleep(1);
        if ((++sp & 255u) == 0u) { if (xb_ld(&bar[XB_TMO])) break; if (sp > XB_SPIN_CAP) { atomicAdd(&bar[XB_TMO], 1u); break; } }
    }
    nloc = mine > 0u ? mine : 1u; nx = cnt > 0u ? cnt : 1u;
}

__device__ __forceinline__ void xcd_barrier(const XcdBarrier& b) {
    asm volatile("s_waitcnt vmcnt(0)" ::: "memory");
    __syncthreads();
    if (threadIdx.x == 0) {
        unsigned* bar = b.bar;
        __builtin_amdgcn_s_waitcnt(0);
        unsigned nloc = b.st[0], nx = b.st[1];
        if (nloc == 0u) { xcd_barrier_complete(bar, b.x, nloc, nx); b.st[0] = nloc; b.st[1] = nx; }
        const unsigned old = xb_add(&bar[XB_XSUB(b.x)], 1u);
        const unsigned gen = old / nloc;
        if (old + 1u == (gen + 1u) * nloc) {
            __builtin_amdgcn_fence(__ATOMIC_RELEASE, "agent");
            asm volatile("s_waitcnt vmcnt(0)" ::: "memory");
            const unsigned og = xb_add(&bar[XB_TOP], 1u);
            const unsigned tg = og / nx;
            if (og + 1u == (tg + 1u) * nx) xb_add(&bar[XB_TOPGEN], 1u);
            else XB_SPIN(xb_ld(&bar[XB_TOPGEN]) == tg, bar);
            __builtin_amdgcn_fence(__ATOMIC_ACQUIRE, "agent");
            xb_add(&bar[XB_XGEN(b.x)], 1u);
            asm volatile("s_waitcnt vmcnt(0)" ::: "memory");
        } else {
            XB_SPIN(xb_ld(&bar[XB_XGEN(b.x)]) == gen, bar);
            __builtin_amdgcn_fence(__ATOMIC_ACQUIRE, "agent");
            asm volatile("s_waitcnt vmcnt(0)" ::: "memory");
        }
    }
    __syncthreads();
}

__global__ void __launch_bounds__(NTHREADS) hybrid_fwd(Args args) {
    extern __shared__ __attribute__((aligned(16))) unsigned char lds_raw[];
    LAS unsigned char* lds = (LAS unsigned char*)lds_raw;
    __shared__ __attribute__((aligned(16))) unsigned xb_st[4];
    cg::grid_group grid = cg::this_grid();
    const int tid = threadIdx.x, lane = tid & 63, wave = __builtin_amdgcn_readfirstlane(tid >> 6);
    if (tid < 4) xb_st[tid] = 0u;
    __syncthreads();
    const XcdBarrier xbar = xcd_barrier_post((unsigned*)args.ws, (volatile LAS unsigned*)xb_st);
    const int G = gridDim.x, bid = blockIdx.x;
    const int gw = bid * NWAVES + wave, NGW = G * NWAVES;
    unsigned char* ws = args.ws;
    const int lo = args.ph_lo, hi = args.ph_hi;
#define IN(k) (lo <= (k) && (k) < hi)
#ifndef REP
#define REP -1
#endif
#define NREP(k) ((REP) == (k) ? 2 : 1)
#define SEAM(k) do { if (IN(k) && IN((k) + 1)) xcd_barrier(xbar); } while (0)
    if (lo > hi) grid.sync();

    if (IN(0)) { p0_prologue(args, lds, gw, NGW, lane, wave); __syncthreads(); }
    SEAM(0);
    if (IN(1)) {
        pg8::Gemm g{(const pg8::bf16_t*)(ws + WS_XN), (const pg8::bf16_t*)(ws + WS_WIN), M, NIN, DM}; pg8::StaticOrder S; S.init(M, NIN, G, bid);
        pg8::EpiStoreBf16 E{(pg8::bf16_t*)(ws + WS_PROJ), NIN};
        pg8::gemm_phase<pg8::EpiStoreBf16, pg8::StaticOrder, true, true>(lds, g, S, E);
        __syncthreads();
    }
    SEAM(1);
    if (IN(2)) p2_qkprep(args, gw, NGW, lane);
    SEAM(2);
    if (IN(3)) {
        const att::bf16* proj = (const att::bf16*)(ws + WS_PROJ);
        for (int u = bid; u < 512; u += G) { const int h = u >> 6, qb = u & 63, kvh = h >> 2;
            att::attn_dense_body<att::bf16>(proj + (size_t)qb * 256 * NIN + C_Q + h * 128, proj + C_K + kvh * 128, proj + C_V + kvh * 128,
                                            (float*)(ws + WS_O) + (size_t)qb * 256 * AW + h * 128, M, (char*)lds_raw, args.in[I_QNW], args.in[I_KNW], (const float*)(ws + WS_TAB), qb * 256);
            __syncthreads(); }
        lru_phase(args, lds, bid, G, 1);
    }
    SEAM(3);
    if (IN(4)) carry_phase(args, gw, NGW, lane);
    SEAM(4);
    if (IN(5)) p4_mix(args, gw, NGW, lane);
    SEAM(5);
    if (IN(6)) {
        pg8::Gemm g{(const pg8::bf16_t*)(ws + WS_XN), (const pg8::bf16_t*)(ws + WS_WOUT), M, DM, MIXW}; pg8::StaticOrder S; S.init(M, DM, G, bid);
        pg8::EpiResidual E{args.in[I_X], args.out, DM};
        pg8::gemm_phase<pg8::EpiResidual, pg8::StaticOrder, true, true>(lds, g, S, E);
    }
#undef IN
#undef SEAM
}

#ifndef N_LAUNCHES
#define N_LAUNCHES 1
#endif
extern "C" void kernel_launch(void* const* d_in, const int* in_sizes, int n_in, void* d_out, int out_size, void* d_ws, size_t ws_size, hipStream_t stream) {
    static int grid = 0;
    if (grid == 0) {
        if (n_in != 15 || in_sizes[0] != M * DM || out_size != M * DM || ws_size < WS_END) { fprintf(stderr, "kernel_launch: shape/workspace mismatch (n_in %d, ws %zu)\n", n_in, ws_size); grid = -1; return; }
        int dev = 0, cus = 0, per_cu = 0;
        (void)hipGetDevice(&dev); (void)hipDeviceGetAttribute(&cus, hipDeviceAttributeMultiprocessorCount, dev);
        if (hipFuncSetAttribute((const void*)hybrid_fwd, hipFuncAttributeMaxDynamicSharedMemorySize, LDS_BYTES) != hipSuccess) { fprintf(stderr, "kernel_launch: hipFuncSetAttribute failed\n"); grid = -1; return; }
        if (hipOccupancyMaxActiveBlocksPerMultiprocessor(&per_cu, (const void*)hybrid_fwd, NTHREADS, LDS_BYTES) != hipSuccess || per_cu < 1) { fprintf(stderr, "kernel_launch: occupancy query gave %d\n", per_cu); per_cu = 1; }
        (void)hipGetLastError();
        grid = cus * 1;
    }
    if (grid < 0) return;
    Args a{};
    for (int i = 0; i < 15; ++i) a.in[i] = (const float*)d_in[i];
    a.out = (float*)d_out; a.ws = (unsigned char*)d_ws;
    if (hipMemsetAsync(d_ws, 0, 16384, stream) != hipSuccess) { fprintf(stderr, "kernel_launch: hipMemsetAsync failed\n"); return; }
    if (N_LAUNCHES == 1) {
        a.ph_lo = 0; a.ph_hi = 7;
        void* kargs[] = {&a};
        hipError_t e = hipLaunchCooperativeKernel((const void*)hybrid_fwd, dim3(grid), dim3(NTHREADS), kargs, LDS_BYTES, stream);
        if (e != hipSuccess) fprintf(stderr, "cooperative launch failed: %s (grid %d)\n", hipGetErrorString(e), grid);
    } else {
        for (int p = 0; p < 7; ++p) { a.ph_lo = p; a.ph_hi = p + 1; hipLaunchKernelGGL(hybrid_fwd, dim3(grid), dim3(NTHREADS), LDS_BYTES, stream, a); }
    }
}
```

```cpp
#include <hip/hip_runtime.h>
#include <hip/hip_bf16.h>
#include <hip/hip_cooperative_groups.h>
#include <cstdio>
#include <cstdint>
namespace cg = cooperative_groups;
namespace pg8 {
#define PG8_LAS __attribute__((address_space(3)))
typedef unsigned short bf16_t;
typedef short bf16x8 __attribute__((ext_vector_type(8)));
typedef float f32x4 __attribute__((ext_vector_type(4)));
typedef unsigned u32x4 __attribute__((ext_vector_type(4)));
constexpr int BM = 256, BK = 64, HALF = 128, HTB = HALF * BK * 2  , STAGE_BYTES = 8 * HTB, NXCD = 8, WGM = 8;

__host__ __device__ __forceinline__ int lds_byte(int r, int c) { const int st = (r >> 4) * 2 + (c >> 5), rr = r & 15, cc = c & 31, ob = rr * 64 + cc * 2; return st * 1024 + (ob ^ (((ob >> 9) & 1) << 5)); }
__host__ __device__ __forceinline__ void stage_rc(int b, int& R, int& C) { const int st = b / 1024, sb = b % 1024, swz = sb ^ (((sb >> 9) & 1) << 5); R = (st >> 1) * 16 + swz / 64; C = (st & 1) * 32 + (swz % 64) / 2; }
__host__ __device__ __forceinline__ int perm32(int rho) { const int n = rho >> 4, i = rho & 15; return 8 * (i >> 2) + 4 * n + (i & 3); }

struct Unit { int pm, pn; };
struct Gemm { const bf16_t* A; const bf16_t* Bt; int M, N, K; };

struct StaticOrder {
    int nM, nN, nwg, G, c;
    __host__ __device__ void init(int M, int N, int G_, int c_) { nM = M / BM; nN = N / BM; nwg = nM * nN; G = G_; c = c_; }
    __host__ __device__ bool next(int i, Unit& u) const {
        const long L = (long)i * G + c; if (L >= nwg) return false;
        int wgid = (int)L; { const int q = nwg / NXCD, r = nwg % NXCD, xcd = wgid % NXCD, off = wgid / NXCD; wgid = (xcd < r ? xcd * (q + 1) : r * (q + 1) + (xcd - r) * q) + off; }
        const int nig = WGM * nN, gid = wgid / nig, fm = gid * WGM, gsz = (nM - fm) < WGM ? (nM - fm) : WGM;
        u.pm = fm + ((wgid % nig) % gsz); u.pn = (wgid % nig) / gsz; return true;
    }
    __device__ __forceinline__ void a_ready(const Unit&) const {}
    __device__ __forceinline__ void done(const Unit&) const {}
};

__device__ __forceinline__ unsigned cvt_pk_bf16(float lo, float hi) { unsigned r; asm volatile("v_cvt_pk_bf16_f32 %0, %1, %2" : "=v"(r) : "v"(lo), "v"(hi)); return r; }
__device__ __forceinline__ void store16_wt(void* p, u32x4 v) { asm volatile("global_store_dwordx4 %0, %1, off sc1" :: "v"(p), "v"(v) : "memory"); }
struct EpiStoreBf16 {
    static constexpr bool PERM = true, AFTER_DRAIN = false;
    bf16_t* O; int ldc;
    __device__ __forceinline__ void operator()(const f32x4 (&acc)[2][2][4][2], const Unit& u, int wr, int wc, int fr, int fq) const {
        const int row0 = u.pm * BM + wr * 64 + fr; const int col0 = u.pn * BM + wc * 32 + 8 * fq;
#pragma unroll
        for (int ai = 0; ai < 2; ++ai)
#pragma unroll
            for (int m = 0; m < 4; ++m) { bf16_t* rowp = O + (size_t)(row0 + ai * HALF + m * 16) * ldc + col0;
#pragma unroll
                for (int bj = 0; bj < 2; ++bj) { const f32x4 v0 = acc[ai][bj][m][0], v1 = acc[ai][bj][m][1];
                    u32x4 w; w.x = cvt_pk_bf16(v0[0], v0[1]); w.y = cvt_pk_bf16(v0[2], v0[3]); w.z = cvt_pk_bf16(v1[0], v1[1]); w.w = cvt_pk_bf16(v1[2], v1[3]);
                    store16_wt(rowp + bj * HALF, w); } }
    }
};
struct EpiResidual {
    static constexpr bool PERM = false, AFTER_DRAIN = false;
    const float* x; float* out; int ldc;
    __device__ __forceinline__ void operator()(const f32x4 (&acc)[2][2][4][2], const Unit& u, int wr, int wc, int fr, int fq) const {
        const int row0 = u.pm * BM + wr * 64 + fr; const int col0 = u.pn * BM + wc * 32 + 4 * fq;
#pragma unroll
        for (int ai = 0; ai < 2; ++ai)
#pragma unroll
            for (int m = 0; m < 4; ++m) { const size_t off = (size_t)(row0 + ai * HALF + m * 16) * ldc + col0;
#pragma unroll
                for (int bj = 0; bj < 2; ++bj)
#pragma unroll
                    for (int n = 0; n < 2; ++n) { const f32x4 xv = *(const f32x4*)(x + off + bj * HALF + n * 16); *(f32x4*)(out + off + bj * HALF + n * 16) = xv + acc[ai][bj][m][n]; } }
    }
};
template <class Epi, class Sched, bool ALIGN_EPI = false, bool SP2 = false>
__device__ __forceinline__ void gemm_phase(PG8_LAS unsigned char* lds, const Gemm g, const Sched& S, const Epi& E) {
    const int tid = threadIdx.x, wid = __builtin_amdgcn_readfirstlane(tid >> 6), lane = tid & 63, wr = wid >> 2, wc = wid & 3, fr = lane & 15, fq = lane >> 4;
    const int K = g.K, nt = K / BK;
    unsigned voffA[2], voffB[2];
#pragma unroll
    for (int i = 0; i < 2; ++i) { int R, C; stage_rc(tid * 16 + i * 8192, R, C); const int Rb = Epi::PERM ? ((R & ~31) + perm32(R & 31)) : R;
        voffA[i] = (unsigned)(R * K + C) * 2u; voffB[i] = (unsigned)(Rb * K + C) * 2u; }
    const size_t kstep = (size_t)(BK * 2);
    const size_t hstep = (size_t)HALF * K * 2;
    const size_t tstep = 2 * hstep;
    const unsigned ldsw = (unsigned)wid * 1024u;
    const int aoff = lds_byte(wr * 64 + fr, fq * 8), boff = lds_byte(wc * 32 + fr, fq * 8);
#define PG8_SA(b, h) (((b) * 2 + (h)) * HTB)
#define PG8_SB(b, h) ((4 + (b) * 2 + (h)) * HTB)
#define PG8_STAGE(bufoff, gbase, voff) do { _Pragma("unroll") for (int _i = 0; _i < 2; ++_i) \
        __builtin_amdgcn_global_load_lds((const unsigned*)((const char*)(gbase) + (voff)[_i]), (PG8_LAS unsigned*)(lds + (bufoff) + ldsw + _i * 8192), 16, 0, 0); } while (0)
#define PG8_LDA(dst, b, h) do { _Pragma("unroll") for (int m = 0; m < 4; ++m) _Pragma("unroll") for (int k = 0; k < 2; ++k) dst[m][k] = *(const PG8_LAS bf16x8*)(lds + PG8_SA(b, h) + aoff + m * 2048 + k * 1024); } while (0)
#define PG8_LDB(dst, b, h) do { _Pragma("unroll") for (int n = 0; n < 2; ++n) _Pragma("unroll") for (int k = 0; k < 2; ++k) dst[n][k] = *(const PG8_LAS bf16x8*)(lds + PG8_SB(b, h) + boff + n * 2048 + k * 1024); } while (0)
#define PG8_MMA(ai, bj, At, Bt) do { __builtin_amdgcn_s_setprio(1); _Pragma("unroll") for (int m = 0; m < 4; ++m) _Pragma("unroll") for (int n = 0; n < 2; ++n) _Pragma("unroll") for (int k = 0; k < 2; ++k) \
        acc[ai][bj][m][n] = __builtin_amdgcn_mfma_f32_16x16x32_bf16(Bt[n][k], At[m][k], acc[ai][bj][m][n], 0, 0, 0); __builtin_amdgcn_s_setprio(0); } while (0)
#define PG8_WAIT_V(n) asm volatile("s_waitcnt vmcnt(" #n ")" ::: "memory")
#define PG8_WAIT_L(n) asm volatile("s_waitcnt lgkmcnt(" #n ")" ::: "memory")
#define PG8_BAR __builtin_amdgcn_s_barrier()
#define PG8_SCHED __builtin_amdgcn_sched_barrier(0)
    Unit cur, nxt; int ui = 0;
    if (!S.next(0, cur)) return;
    f32x4 acc[2][2][4][2];
#pragma unroll
    for (int a = 0; a < 2; ++a)
#pragma unroll
        for (int b = 0; b < 2; ++b)
#pragma unroll
            for (int m = 0; m < 4; ++m)
#pragma unroll
                for (int n = 0; n < 2; ++n) acc[a][b][m][n] = (f32x4){0.f, 0.f, 0.f, 0.f};
    bf16x8 At[4][2], B0[2][2], B1[2][2];
    const char* cA = (const char*)g.A + (size_t)cur.pm * tstep; const char* cB = (const char*)g.Bt + (size_t)cur.pn * tstep;
    S.a_ready(cur);
    if constexpr (SP2) {
        PG8_STAGE(PG8_SB(0, 0), cB, voffB); PG8_STAGE(PG8_SB(0, 1), cB + hstep, voffB); PG8_STAGE(PG8_SA(0, 0), cA, voffA); PG8_STAGE(PG8_SA(0, 1), cA + hstep, voffA);
        if (wr == 1) PG8_BAR;
        PG8_WAIT_V(2); PG8_BAR;
        PG8_STAGE(PG8_SB(1, 0), cB + kstep, voffB); PG8_STAGE(PG8_SA(1, 0), cA + kstep, voffA); PG8_STAGE(PG8_SB(1, 1), cB + hstep + kstep, voffB);
        PG8_WAIT_V(6); PG8_BAR;
    } else {
        PG8_STAGE(PG8_SB(0, 0), cB, voffB); PG8_STAGE(PG8_SA(0, 0), cA, voffA); PG8_STAGE(PG8_SB(0, 1), cB + hstep, voffB); PG8_STAGE(PG8_SA(0, 1), cA + hstep, voffA);
        if (wr == 1) PG8_BAR;
        PG8_WAIT_V(4); PG8_BAR;
        PG8_STAGE(PG8_SB(1, 0), cB + kstep, voffB); PG8_STAGE(PG8_SA(1, 0), cA + kstep, voffA); PG8_STAGE(PG8_SB(1, 1), cB + hstep + kstep, voffB);
        PG8_WAIT_V(6); PG8_BAR;
    }
    for (;;) {
        const bool has_next = S.next(ui + 1, nxt);
        const char* nA = has_next ? (const char*)g.A + (size_t)nxt.pm * tstep : cA; const char* nB = has_next ? (const char*)g.Bt + (size_t)nxt.pn * tstep : cB;
        for (int t = 0; t < nt; t += 2) {
            const bool last = (t == nt - 2);
            const char* a1 = cA + (size_t)(t + 1) * kstep;
            const char* a2 = last ? nA : cA + (size_t)(t + 2) * kstep; const char* b2 = last ? nB : cB + (size_t)(t + 2) * kstep;
            const char* a3 = a2 + kstep; const char* b3 = b2 + kstep;
            if (last && has_next) S.a_ready(nxt);
            if constexpr (SP2) {
            PG8_LDB(B0, 0, 0); PG8_LDB(B1, 0, 1); PG8_SCHED; PG8_LDA(At, 0, 0); PG8_STAGE(PG8_SA(1, 1), a1 + hstep, voffA);
            PG8_WAIT_V(8); PG8_WAIT_L(0); PG8_BAR; PG8_MMA(0, 0, At, B0); PG8_MMA(0, 1, At, B1); PG8_BAR; PG8_SCHED;
            PG8_LDA(At, 0, 1); PG8_STAGE(PG8_SB(0, 0), b2, voffB); PG8_STAGE(PG8_SB(0, 1), b2 + hstep, voffB); PG8_STAGE(PG8_SA(0, 0), a2, voffA);
            PG8_WAIT_V(8); PG8_WAIT_L(0); PG8_BAR; PG8_MMA(1, 0, At, B0); PG8_MMA(1, 1, At, B1); PG8_BAR; PG8_SCHED;
            PG8_LDB(B0, 1, 0); PG8_LDB(B1, 1, 1); PG8_SCHED; PG8_LDA(At, 1, 0); PG8_STAGE(PG8_SA(0, 1), a2 + hstep, voffA);
            PG8_WAIT_V(8); PG8_WAIT_L(0); PG8_BAR; PG8_MMA(0, 0, At, B0); PG8_MMA(0, 1, At, B1); PG8_BAR; PG8_SCHED;
            PG8_LDA(At, 1, 1); PG8_STAGE(PG8_SB(1, 0), b3, voffB); PG8_STAGE(PG8_SB(1, 1), b3 + hstep, voffB); PG8_STAGE(PG8_SA(1, 0), a3, voffA);
            PG8_WAIT_V(8); PG8_WAIT_L(0); PG8_BAR; PG8_MMA(1, 0, At, B0); PG8_MMA(1, 1, At, B1); PG8_BAR; PG8_SCHED;
            } else {
            PG8_LDB(B0, 0, 0); PG8_SCHED; PG8_LDA(At, 0, 0); PG8_STAGE(PG8_SA(1, 1), a1 + hstep, voffA);
            PG8_WAIT_L(8); PG8_BAR; PG8_WAIT_L(0); PG8_MMA(0, 0, At, B0); PG8_BAR; PG8_SCHED;
            PG8_LDB(B1, 0, 1); PG8_STAGE(PG8_SB(0, 0), b2, voffB);
            PG8_BAR; PG8_WAIT_L(0); PG8_MMA(0, 1, At, B1); PG8_BAR;
            PG8_LDA(At, 0, 1); PG8_STAGE(PG8_SA(0, 0), a2, voffA);
            PG8_BAR; PG8_WAIT_L(0); PG8_MMA(1, 0, At, B0); PG8_BAR; PG8_SCHED;
            PG8_STAGE(PG8_SB(0, 1), b2 + hstep, voffB);
            PG8_WAIT_V(6); PG8_BAR; PG8_MMA(1, 1, At, B1); PG8_BAR;
            PG8_LDB(B0, 1, 0); PG8_SCHED; PG8_LDA(At, 1, 0); PG8_STAGE(PG8_SA(0, 1), a2 + hstep, voffA);
            PG8_WAIT_L(8); PG8_BAR; PG8_WAIT_L(0); PG8_MMA(0, 0, At, B0); PG8_BAR; PG8_SCHED;
            PG8_LDB(B1, 1, 1); PG8_STAGE(PG8_SB(1, 0), b3, voffB);
            PG8_BAR; PG8_WAIT_L(0); PG8_MMA(0, 1, At, B1); PG8_BAR;
            PG8_LDA(At, 1, 1); PG8_STAGE(PG8_SA(1, 0), a3, voffA);
            PG8_BAR; PG8_WAIT_L(0); PG8_MMA(1, 0, At, B0); PG8_BAR; PG8_SCHED;
            PG8_STAGE(PG8_SB(1, 1), b3 + hstep, voffB);
            PG8_WAIT_V(6); PG8_BAR; PG8_MMA(1, 1, At, B1); PG8_BAR;
            }
        }
        if constexpr (ALIGN_EPI) { if (wr == 0) PG8_BAR; }
        if constexpr (!Epi::AFTER_DRAIN) { E(acc, cur, wr, wc, fr, fq); S.done(cur); }
        if (!has_next) break;
#pragma unroll
        for (int a = 0; a < 2; ++a)
#pragma unroll
            for (int b = 0; b < 2; ++b)
#pragma unroll
                for (int m = 0; m < 4; ++m)
#pragma unroll
                    for (int n = 0; n < 2; ++n) acc[a][b][m][n] = (f32x4){0.f, 0.f, 0.f, 0.f};
        cur = nxt; cA = nA; cB = nB; ++ui;
        if constexpr (ALIGN_EPI) { if (wr == 1) PG8_BAR; }
    }
    PG8_WAIT_V(0);
    if constexpr (!ALIGN_EPI) { if (wr == 0) PG8_BAR; }
    PG8_BAR;
    if constexpr (Epi::AFTER_DRAIN) { E.fused(acc, cur, wr, wc, fr, fq, lds, wid, lane); S.done(cur); }
#undef PG8_SA
#undef PG8_SB
#undef PG8_STAGE
#undef PG8_LDA
#undef PG8_LDB
#undef PG8_MMA
#undef PG8_WAIT_V
#undef PG8_WAIT_L
#undef PG8_BAR
#undef PG8_SCHED
}
}
namespace att {
using bf16 = __hip_bfloat16;
constexpr int   D = 128, NW = 8, QBLK = 32, KVBLK = 64;
constexpr float SCALE = 0.088388347648318440f;
constexpr float THR2 = 11.f;
constexpr float QSCALE = SCALE * 1.4426950408889634f;
constexpr int SDEPTH = 1;
constexpr int LDQ = 4608, LDK = 4608, LDO = 1024;
constexpr size_t SHM_V = KVBLK * D * 2, SHM_K = KVBLK * D * 2, SHM_ATTN = 2 * SHM_V + 2 * SHM_K + NW * 64 * 4;
using bf16x8 = __attribute__((ext_vector_type(8))) short;
using s16x4  = __attribute__((ext_vector_type(4))) short;
using f32x16 = __attribute__((ext_vector_type(16))) float;
using f32x8  = __attribute__((ext_vector_type(8))) float;
using u32x4  = __attribute__((ext_vector_type(4))) unsigned;
#define KSWZ(row, colB) ((row) * 256 + ((colB) ^ (((row) & 7) << 4)))
#define SBAR() __builtin_amdgcn_sched_barrier(0)
__device__ __forceinline__ int crow(int r, int hi) { return (r & 3) + 8 * (r >> 2) + 4 * hi; }
__device__ __forceinline__ unsigned cvtpk(float lo, float hi) {
  unsigned r; asm volatile("v_cvt_pk_bf16_f32 %0, %1, %2" : "=v"(r) : "v"(lo), "v"(hi)); return r;
}
template <typename TIn> struct Stage;
template <> struct Stage<bf16>  { using T = bf16x8;
  __device__ static __forceinline__ T ld8(const bf16* p) { return *reinterpret_cast<const bf16x8*>(p); }
  __device__ static __forceinline__ bf16x8 tobf(T x) { return x; } };
template <> struct Stage<float> { using T = f32x8;
  __device__ static __forceinline__ T ld8(const float* p) { return *reinterpret_cast<const f32x8*>(p); }
  __device__ static __forceinline__ bf16x8 tobf(T x) {
    u32x4 w = {cvtpk(x[0], x[1]), cvtpk(x[2], x[3]), cvtpk(x[4], x[5]), cvtpk(x[6], x[7])}; return *reinterpret_cast<bf16x8*>(&w); } };

__device__ __forceinline__ void partialSM(f32x16& p0) {
#pragma unroll
  for (int r = 0; r < 16; ++r) p0[r] = __builtin_amdgcn_exp2f(p0[r]);
}
__device__ __forceinline__ void finishSM(f32x16& p0, f32x16& p1, float& l_reg, bf16x8& pa0, bf16x8& pa1, bf16x8& pa2, bf16x8& pa3) {
  for (int r = 0; r < 16; ++r) p1[r] = __builtin_amdgcn_exp2f(p1[r]);
  float ps = 0; for (int r = 0; r < 16; ++r) ps += p0[r]; for (int r = 0; r < 16; ++r) ps += p1[r];
  { auto rr = __builtin_amdgcn_permlane32_swap(__float_as_uint(ps), __float_as_uint(ps), false, false);
    ps = __uint_as_float(rr[0]) + __uint_as_float(rr[1]); }
  l_reg += ps;
#define PK4(P, BASE, OUT) do { unsigned a0 = cvtpk(P[BASE + 0], P[BASE + 1]), a1 = cvtpk(P[BASE + 2], P[BASE + 3]);   \
    unsigned b0 = cvtpk(P[BASE + 4], P[BASE + 5]), b1 = cvtpk(P[BASE + 6], P[BASE + 7]);                              \
    auto r0 = __builtin_amdgcn_permlane32_swap(a0, b0, false, false); auto r1 = __builtin_amdgcn_permlane32_swap(a1, b1, false, false); \
    u32x4 w = {r0[0], r1[0], r0[1], r1[1]}; OUT = *reinterpret_cast<bf16x8*>(&w); } while (0)
  PK4(p0, 0, pa0); PK4(p0, 8, pa1); PK4(p1, 0, pa2); PK4(p1, 8, pa3);
#undef PK4
}
__device__ __forceinline__ void qkt(f32x16& p0, f32x16& p1, const bf16* Ks, const bf16x8* qr, const f32x16& negm, int r32, int hi) {
  const char* kb = (const char*)Ks + r32 * 32 + hi * 16;
#pragma unroll
  for (int d0 = 0; d0 < 8; ++d0) {
    bf16x8 b0 = *reinterpret_cast<const bf16x8*>(kb + d0 * 2048);
    bf16x8 b1 = *reinterpret_cast<const bf16x8*>(kb + d0 * 2048 + 1024);
    if (d0 == 0) { p0 = __builtin_amdgcn_mfma_f32_32x32x16_bf16(b0, qr[0], negm, 0, 0, 0); p1 = __builtin_amdgcn_mfma_f32_32x32x16_bf16(b1, qr[0], negm, 0, 0, 0); }
    else { p0 = __builtin_amdgcn_mfma_f32_32x32x16_bf16(b0, qr[d0], p0, 0, 0, 0); p1 = __builtin_amdgcn_mfma_f32_32x32x16_bf16(b1, qr[d0], p1, 0, 0, 0); } }
}
__device__ __forceinline__ int v_st(int k, int c) { const int kk = (k & ~0xC) | ((k & 4) << 1) | ((k & 8) >> 1); return ((kk >> 3) * 4 + (c >> 5)) * 512 + ((kk & 7) * 32 + (c & 31)) * 2; }
__device__ __forceinline__ int v_rd_base(int lane) { return ((lane & 3) << 3) | (((lane >> 2) & 3) << 6) | (((lane >> 4) & 1) << 5) | (((lane >> 5) & 1) << 8); }
constexpr int v_rd_off(int d0, int ks, int half) { return d0 * 512 + ks * 4096 + half * 2048; }
template <int OFF> __device__ __forceinline__ s16x4 tr_read(int vb) {
  s16x4 r; asm volatile("ds_read_b64_tr_b16 %0, %1 offset:%2" : "=&v"(r) : "v"(vb), "i"(OFF) : "memory"); return r;
}
template <int D0> __device__ __forceinline__ void pv_one(f32x16& od, int vb, bf16x8 pa0, bf16x8 pa1, bf16x8 pa2, bf16x8 pa3) {
  const s16x4 l0 = tr_read<v_rd_off(D0, 0, 0)>(vb), h0 = tr_read<v_rd_off(D0, 0, 1)>(vb), l1 = tr_read<v_rd_off(D0, 1, 0)>(vb), h1 = tr_read<v_rd_off(D0, 1, 1)>(vb);
  const s16x4 l2 = tr_read<v_rd_off(D0, 2, 0)>(vb), h2 = tr_read<v_rd_off(D0, 2, 1)>(vb), l3 = tr_read<v_rd_off(D0, 3, 0)>(vb), h3 = tr_read<v_rd_off(D0, 3, 1)>(vb);
  asm volatile("s_waitcnt lgkmcnt(0)" ::: "memory"); SBAR();
#define PK(L, H) (bf16x8){L[0], L[1], L[2], L[3], H[0], H[1], H[2], H[3]}
  od = __builtin_amdgcn_mfma_f32_32x32x16_bf16(pa0, PK(l0, h0), od, 0, 0, 0);
  od = __builtin_amdgcn_mfma_f32_32x32x16_bf16(pa1, PK(l1, h1), od, 0, 0, 0);
  od = __builtin_amdgcn_mfma_f32_32x32x16_bf16(pa2, PK(l2, h2), od, 0, 0, 0);
  od = __builtin_amdgcn_mfma_f32_32x32x16_bf16(pa3, PK(l3, h3), od, 0, 0, 0);
#undef PK
}
__device__ __forceinline__ void pv_d0(f32x16* o, int vb, bf16x8 pa0, bf16x8 pa1, bf16x8 pa2, bf16x8 pa3) {
  pv_one<0>(o[0], vb, pa0, pa1, pa2, pa3); pv_one<1>(o[1], vb, pa0, pa1, pa2, pa3); pv_one<2>(o[2], vb, pa0, pa1, pa2, pa3); pv_one<3>(o[3], vb, pa0, pa1, pa2, pa3);
}

template <typename TQ>
__device__ __forceinline__ void attn_dense_body(const TQ* __restrict__ Qb, const bf16* __restrict__ Kh, const bf16* __restrict__ Vh,
                                                float* __restrict__ Ob, int seq, char* lds, const float* __restrict__ qnw, const float* __restrict__ knw, const float* __restrict__ tab, int t0) {
  using SQ = Stage<TQ>;
  typedef __attribute__((address_space(3))) unsigned lds_u32;
  const int tid = threadIdx.x, lane = tid & 63, r32 = lane & 31, hi = lane >> 5;
  const int wid = __builtin_amdgcn_readfirstlane(tid >> 6);
  char* K_lds = lds; char* V_lds = lds + 4 * SHM_K;
  float* ws = (float*)(lds + 4 * SHM_V + 4 * SHM_K) + wid * 64; float* li_l = ws; float* al_l = ws + 32;
  float l_reg = 0; f32x16 o[4] = {}; bf16x8 qr[8]; f32x16 negm = {}; asm volatile("" : "+v"(negm));
  const TQ* Qw = Qb + (long)(wid * QBLK + r32) * LDQ + hi * 8;
  {
    const int t = t0 + wid * QBLK + r32; float x[8][8]; float ss = 0.f;
#pragma unroll
    for (int d0 = 0; d0 < 8; ++d0) { const u32x4 raw = *reinterpret_cast<const u32x4*>(Qw + d0 * 16);
#pragma unroll
      for (int k = 0; k < 4; ++k) { x[d0][2 * k] = __uint_as_float(raw[k] << 16); x[d0][2 * k + 1] = __uint_as_float(raw[k] & 0xffff0000u); ss += x[d0][2 * k] * x[d0][2 * k] + x[d0][2 * k + 1] * x[d0][2 * k + 1]; } }
    { auto rr = __builtin_amdgcn_permlane32_swap(__float_as_uint(ss), __float_as_uint(ss), false, false); ss = __uint_as_float(rr[0]) + __uint_as_float(rr[1]); }
    const float rstd = rsqrtf(ss * (1.f / 128.f) + 1e-6f); float n2 = 0.f;
#pragma unroll
    for (int d0 = 0; d0 < 8; ++d0) { const float* wp = qnw + d0 * 16 + hi * 8;
#pragma unroll
      for (int e = 0; e < 8; ++e) { x[d0][e] *= rstd * wp[e]; n2 += x[d0][e] * x[d0][e]; } }
    { auto rr = __builtin_amdgcn_permlane32_swap(__float_as_uint(n2), __float_as_uint(n2), false, false); n2 = __uint_as_float(rr[0]) + __uint_as_float(rr[1]); }
    float kwm = fmaxf(fabsf(knw[2 * lane]), fabsf(knw[2 * lane + 1]));
#pragma unroll
    for (int o_ = 1; o_ < 64; o_ <<= 1) kwm = fmaxf(kwm, __shfl_xor(kwm, o_));
    const float mref = fminf(sqrtf(n2) * QSCALE * 11.313708499f * kwm * 1.0005f, 60.f);
#pragma unroll
    for (int r = 0; r < 16; ++r) negm[r] = -mref;
    asm volatile("" : "+v"(negm));
#pragma unroll
    for (int half = 0; half < 2; ++half) { const int pos = half ? (t & 63) : (t >> 6);
#pragma unroll
      for (int b = 0; b < 2; ++b) { const float* tp = tab + (pos * 32 + b * 16 + hi * 8) * 2;
#pragma unroll
        for (int e = 0; e < 8; ++e) { const float c = tp[2 * e], sn = tp[2 * e + 1]; const float x1 = x[half * 4 + b][e], x2 = x[half * 4 + b + 2][e];
          x[half * 4 + b][e] = (x1 * c - x2 * sn) * QSCALE; x[half * 4 + b + 2][e] = (x2 * c + x1 * sn) * QSCALE; } } }
#pragma unroll
    for (int d0 = 0; d0 < 8; ++d0) { u32x4 w = {cvtpk(x[d0][0], x[d0][1]), cvtpk(x[d0][2], x[d0][3]), cvtpk(x[d0][4], x[d0][5]), cvtpk(x[d0][6], x[d0][7])}; qr[d0] = *reinterpret_cast<bf16x8*>(&w); }
  }
  const int vb0 = (int)(uintptr_t)V_lds + v_rd_base(lane);
  unsigned koff, voff;
  { const int d0 = wid >> 1, row = (wid & 1) * 32 + (lane >> 1), h_ = lane & 1; koff = (unsigned)(row * LDK + d0 * 16 + h_ * 8) * 2u; }
  { const int sub = wid * 2 + (lane >> 5), kk = (sub >> 2) * 8 + ((lane & 31) >> 2), c = (sub & 3) * 32 + (lane & 3) * 8;
    const int k = (kk & ~0xC) | ((kk & 4) << 1) | ((kk & 8) >> 1); voff = (unsigned)(k * LDK + c) * 2u; }
  const __attribute__((address_space(3))) char* kdst = (const __attribute__((address_space(3))) char*)(unsigned)(uintptr_t)(K_lds + wid * 1024);
  const __attribute__((address_space(3))) char* vdst = (const __attribute__((address_space(3))) char*)(unsigned)(uintptr_t)(V_lds + wid * 1024);
#define DMA(k0, off) do { const char* kt_ = (const char*)Kh + (size_t)(k0) * (LDK * 2); const char* vt_ = (const char*)Vh + (size_t)(k0) * (LDK * 2); \
      __builtin_amdgcn_global_load_lds((const unsigned*)(kt_ + koff), (lds_u32*)(kdst + (off)), 16, 0, 0); \
      __builtin_amdgcn_global_load_lds((const unsigned*)(kt_ + 128 + koff), (lds_u32*)(kdst + (off) + 8192), 16, 0, 0); \
      __builtin_amdgcn_global_load_lds((const unsigned*)(vt_ + voff), (lds_u32*)(vdst + (off)), 16, 0, 0); \
      __builtin_amdgcn_global_load_lds((const unsigned*)(vt_ + 32 * LDK * 2 + voff), (lds_u32*)(vdst + (off) + 8192), 16, 0, 0); } while (0)
#define VWAIT() asm volatile("s_waitcnt vmcnt(0)" ::: "memory")
#define ROT() do { const int t_ = sl_prev; sl_prev = sl_cur; sl_cur = sl_n1; sl_n1 = sl_n2; sl_n2 = t_; } while (0)
#define WAITBAR(N) asm volatile("s_waitcnt vmcnt(" #N ") lgkmcnt(0)\n\ts_barrier" ::: "memory")
  f32x16 pA0, pA1, pB0, pB1; bf16x8 pa0, pa1, pa2, pa3; const int NT = seq / KVBLK;
  DMA(0, 0); DMA(KVBLK, (int)SHM_K); DMA(2 * KVBLK, 2 * (int)SHM_K); WAITBAR(4);
  qkt(pA0, pA1, (const bf16*)K_lds, qr, negm, r32, hi); partialSM(pA0);
  int sl_prev = 0, sl_cur = (int)SHM_K, sl_n1 = 2 * (int)SHM_K, sl_n2 = 3 * (int)SHM_K;
#define STEP(PC0, PC1, PP0, PP1, LD, jn2) do { \
    if (LD) { DMA((jn2) * KVBLK, sl_n2); } SBAR(); \
    qkt(PC0, PC1, (const bf16*)(K_lds + sl_cur), qr, negm, r32, hi); \
    finishSM(PP0, PP1, l_reg, pa0, pa1, pa2, pa3); SBAR(); \
    pv_d0(o, vb0 + sl_prev, pa0, pa1, pa2, pa3); partialSM(PC0); \
    if (LD) { WAITBAR(4); } else { WAITBAR(0); } ROT(); } while (0)
  int j = 1;
  for (; j + 4 < NT; j += 2) {
    STEP(pB0, pB1, pA0, pA1, true, j + 2);
    STEP(pA0, pA1, pB0, pB1, true, j + 3);
  }
  STEP(pB0, pB1, pA0, pA1, true, j + 2);
  STEP(pA0, pA1, pB0, pB1, false, 0);
  STEP(pB0, pB1, pA0, pA1, false, 0);
  finishSM(pB0, pB1, l_reg, pa0, pa1, pa2, pa3); SBAR();
  pv_d0(o, vb0 + sl_prev, pa0, pa1, pa2, pa3);
  if (hi == 0) li_l[r32] = l_reg; asm volatile("s_waitcnt lgkmcnt(0)" ::: "memory");
  float rli[16];
#pragma unroll
  for (int r = 0; r < 16; ++r) rli[r] = __builtin_amdgcn_rcpf(li_l[crow(r, hi)]);
  float* Ow = Ob + (long)(wid * QBLK) * LDO;
#pragma unroll
  for (int r = 0; r < 16; ++r) { int orow = crow(r, hi);
    for (int d0 = 0; d0 < 4; ++d0) Ow[(long)orow * LDO + d0 * 32 + r32] = o[d0][r] * rli[r]; }
#undef DMA
#undef VWAIT
#undef ROT
#undef WAITBAR
#undef STEP
}
#undef KSWZ
#undef SBAR
}
constexpr int M = 16384, DM = 2048, NIN = 4608, AW = 1024, LW = 1024, MIXW = 2048;
constexpr int C_Q = 0, C_K = 1024, C_V = 1280, C_GA = 1536, C_XR = 2560, C_GL = 3584;
constexpr float EPS = 1e-6f;
constexpr int NTHREADS = 512, NWAVES = 8;
constexpr int LDS_BYTES = 135168;
constexpr size_t MiB = 1u << 20;
constexpr size_t WS_WIN = 2 * MiB;
constexpr size_t WS_WOUT = 20 * MiB;
constexpr size_t WS_WG = 28 * MiB;
constexpr size_t WS_TAB = 29 * MiB;
constexpr size_t WS_CARRY = 31 * MiB;
constexpr size_t WS_SUMM = 30 * MiB;
constexpr size_t WS_XN = 32 * MiB;
constexpr size_t WS_PROJ = 96 * MiB;
constexpr size_t WS_O = 240 * MiB;
constexpr size_t WS_HF = 304 * MiB;
constexpr size_t WS_HB = 368 * MiB;
constexpr size_t WS_END = 432 * MiB;

#define LAS __attribute__((address_space(3)))
typedef unsigned short bf16r;
typedef float f32x4 __attribute__((ext_vector_type(4)));
typedef float f32x2 __attribute__((ext_vector_type(2)));
typedef float f32x16 __attribute__((ext_vector_type(16)));
typedef unsigned u32x4 __attribute__((ext_vector_type(4)));
typedef unsigned u32x2 __attribute__((ext_vector_type(2)));
typedef short bf16x8 __attribute__((ext_vector_type(8)));

__device__ __forceinline__ unsigned pk2(float lo, float hi) { unsigned r; asm volatile("v_cvt_pk_bf16_f32 %0, %1, %2" : "=v"(r) : "v"(lo), "v"(hi)); return r; }
__device__ __forceinline__ float bflo(unsigned v) { return __uint_as_float(v << 16); }
__device__ __forceinline__ float bfhi(unsigned v) { return __uint_as_float(v & 0xffff0000u); }
__device__ __forceinline__ float wave_sum(float v) {
#pragma unroll
    for (int o = 1; o < 64; o <<= 1) v += __shfl_xor(v, o);
    return v;
}
__device__ __forceinline__ float sigmoidf_(float z) { return __builtin_amdgcn_rcpf(1.f + __expf(-z)); }

struct Args { const float* in[15]; float* out; unsigned char* ws; int ph_lo, ph_hi; };
enum { I_X = 0, I_NORMW, I_WIN, I_QNW, I_KNW, I_CONVW, I_CONVB, I_WA, I_BA, I_WX, I_BX, I_LAM, I_ANW, I_LNW, I_WOUT };

__device__ __forceinline__ void transpose_item(const float* W, int ldw, int nblk, bf16r* WT, int ldo, LAS float* scr, int item, int lane) {
    const int kb = item / nblk, nb = item % nblk, k0 = 64 * kb, n0 = 32 * nb;
#pragma unroll 8
    for (int i = 0; i < 32; ++i) { const int kk = 2 * i + (lane >> 5); scr[kk * 33 + (lane & 31)] = W[(size_t)(k0 + kk) * ldw + n0 + (lane & 31)]; }
    asm volatile("s_waitcnt lgkmcnt(0)" ::: "memory");
    const int c = lane & 7;
#pragma unroll
    for (int j = 0; j < 4; ++j) { const int n = (lane >> 3) + 8 * j; const LAS float* s = scr + (8 * c) * 33 + n;
        u32x4 o; o.x = pk2(s[0 * 33], s[1 * 33]); o.y = pk2(s[2 * 33], s[3 * 33]); o.z = pk2(s[4 * 33], s[5 * 33]); o.w = pk2(s[6 * 33], s[7 * 33]);
        *(u32x4*)(WT + (size_t)(n0 + n) * ldo + k0 + 8 * c) = o; }
    asm volatile("s_waitcnt lgkmcnt(0)" ::: "memory");
}
__device__ __forceinline__ void p0_prologue(const Args& a, LAS unsigned char* lds, int gw, int NGW, int lane, int wave) {
    unsigned char* ws = a.ws;
    LAS float* scr = (LAS float*)(lds + wave * 16384);
    constexpr int I_IN = (DM / 64) * (NIN / 32), I_OUT = (MIXW / 64) * (DM / 32), I_G = 32 * 8;
    for (int it = gw; it < I_IN + I_OUT + I_G; it += NGW) {
        if (it < I_IN) transpose_item(a.in[I_WIN], NIN, NIN / 32, (bf16r*)(ws + WS_WIN), DM, scr, it, lane);
        else if (it < I_IN + I_OUT) transpose_item(a.in[I_WOUT], DM, DM / 32, (bf16r*)(ws + WS_WOUT), MIXW, scr, it - I_IN, lane);
        else { const int r = it - I_IN - I_OUT, mat = r >> 3, sub = r & 7, which = mat >> 4, db = mat & 15;
            const float* src = (which ? a.in[I_WX] : a.in[I_WA]) + (size_t)db * 128 * 128;
            bf16r* dst = (bf16r*)(ws + WS_WG) + (size_t)db * 256 * 128 + (size_t)which * 128 * 128;
            transpose_item(src, 128, 4, dst, 128, scr, sub, lane); }
    }
    { const int e = gw * 64 + lane;
      if (e < 256 * 32) { const int pos = e >> 5, i = e & 31;
        const float invf = __builtin_amdgcn_exp2f(-(float)i * 0.41524101186092029f);
        const float ang = (float)pos * invf;
        const double ad = (double)ang; const double k = __builtin_rint(ad * 0.63661977236758134);
        const double r = __builtin_fma(-k, 1.5707963267948966, ad); const double r2 = r * r;
        const double sn = r * (1.0 + r2 * (-1.0 / 6 + r2 * (1.0 / 120 + r2 * (-1.0 / 5040 + r2 * (1.0 / 362880 + r2 * (-1.0 / 39916800))))));
        const double cs = 1.0 + r2 * (-0.5 + r2 * (1.0 / 24 + r2 * (-1.0 / 720 + r2 * (1.0 / 40320 + r2 * (-1.0 / 3628800 + r2 * (1.0 / 479001600))))));
        const int q = ((int)k) & 3;
        const double c_ = (q == 0) ? cs : (q == 1) ? -sn : (q == 2) ? -cs : sn;
        const double s_ = (q == 0) ? sn : (q == 1) ? cs : (q == 2) ? -sn : -cs;
        f32x2 o; o.x = (float)c_; o.y = (float)s_; ((f32x2*)(ws + WS_TAB))[e] = o; } }
    const float* x = a.in[I_X]; const f32x4* nw = (const f32x4*)a.in[I_NORMW] + lane;
    for (int m = gw; m < M; m += NGW) {
        const f32x4* xr = (const f32x4*)(x + (size_t)m * DM) + lane; f32x4 v[8]; float s = 0.f;
#pragma unroll
        for (int j = 0; j < 8; ++j) { v[j] = xr[64 * j]; s += (v[j].x * v[j].x + v[j].y * v[j].y) + (v[j].z * v[j].z + v[j].w * v[j].w); }
        const float rstd = rsqrtf(wave_sum(s) * (1.f / DM) + EPS);
        u32x2* o8 = (u32x2*)((bf16r*)(ws + WS_XN) + (size_t)m * DM) + lane;
#pragma unroll
        for (int j = 0; j < 8; ++j) { const f32x4 w = nw[64 * j]; u32x2 o; o.x = pk2(v[j].x * rstd * w.x, v[j].y * rstd * w.y); o.y = pk2(v[j].z * rstd * w.z, v[j].w * rstd * w.w); o8[64 * j] = o; }
    }
}

__device__ __forceinline__ void p2_qkprep(const Args& a, int gw, int NGW, int lane) {
    bf16r* proj = (bf16r*)(a.ws + WS_PROJ); const float* tab = (const float*)(a.ws + WS_TAB);
    const f32x2 kw = ((const f32x2*)a.in[I_KNW])[lane];
    const int i0 = (2 * lane) & 31; const float sgn = (lane & 16) ? 1.f : -1.f;
    for (int t0 = gw; t0 < M; t0 += 4 * NGW) {
        unsigned v[4][2]; f32x4 cs[4]; unsigned* rowp[4];
#pragma unroll
        for (int q = 0; q < 4; ++q) { const int t = min(t0 + q * NGW, M - 1); const int pos = (lane < 32) ? (t >> 6) : (t & 63);
            cs[q] = *(const f32x4*)(tab + (pos * 32 + i0) * 2);
            rowp[q] = (unsigned*)(proj + (size_t)t * NIN + C_K) + lane; v[q][0] = rowp[q][0]; v[q][1] = rowp[q][64]; }
#pragma unroll
        for (int q = 0; q < 4; ++q) { if (t0 + q * NGW >= M) break;
#pragma unroll
            for (int hh = 0; hh < 2; ++hh) {
                const float x0 = bflo(v[q][hh]), x1 = bfhi(v[q][hh]);
                const float rstd = rsqrtf(wave_sum(x0 * x0 + x1 * x1) * (1.f / 128.f) + EPS);
                const float y0 = x0 * rstd * kw.x, y1 = x1 * rstd * kw.y;
                const float p0 = __shfl_xor(y0, 16), p1 = __shfl_xor(y1, 16);
                rowp[q][hh * 64] = pk2(y0 * cs[q].x + sgn * p0 * cs[q].y, y1 * cs[q].z + sgn * p1 * cs[q].w); } }
    }
}

constexpr int L_SUM = 0, L_CW = 8192, L_WT = 16384;
#define KSWZ_(row, colB) ((row) * 256 + ((colB) ^ (((row) & 7) << 4)))
__device__ __forceinline__ int crow_(int r, int hi) { return (r & 3) + 8 * (r >> 2) + 4 * hi; }
template <int DIR>
__device__ __forceinline__ void lru_unit(const Args& a, LAS unsigned char* lds, int ck, int blk, bool load_w) {
    int tid = threadIdx.x; asm volatile("" : "+v"(tid));
    const int lane = tid & 63, r32 = lane & 31, hi = lane >> 5;
    const int w = __builtin_amdgcn_readfirstlane(tid >> 6);
    constexpr int d = DIR;
    unsigned char* ws = a.ws;
    const bf16r* proj = (const bf16r*)(ws + WS_PROJ);
    LAS float* CWl = (LAS float*)(lds + L_CW);
    LAS f32x2* SUM = (LAS f32x2*)(lds + L_SUM);
    __syncthreads();
    if (load_w) {
        const bf16r* Wt = (const bf16r*)(ws + WS_WG) + (size_t)(d * 8 + blk) * 256 * 128;
#pragma unroll
        for (int i = 0; i < 8; ++i) { const int p = tid + 512 * i, row = p >> 4, c16 = p & 15;
            const u32x4 v = *(const u32x4*)(Wt + row * 128 + c16 * 8); *(LAS u32x4*)(lds + L_WT + KSWZ_(row, c16 * 16)) = v; }
        const float* cw = a.in[I_CONVW]; const float* cbias = a.in[I_CONVB];
        for (int e = tid; e < 640; e += 512) CWl[e] = e < 512 ? cw[(e >> 7) * 1024 + blk * 128 + (e & 127)] : cbias[blk * 128 + (e - 512)];
    }
    __syncthreads();
    const int t = ck * 256 + w * 32 + r32;
    bf16x8 A[8];
#pragma unroll
    for (int kk = 0; kk < 8; ++kk) { const int c0 = kk * 16 + hi * 8;
        f32x4 acc0 = *(const LAS f32x4*)(CWl + 512 + c0), acc1 = *(const LAS f32x4*)(CWl + 512 + c0 + 4);
#pragma unroll
        for (int j = 0; j < 4; ++j) { const int tt = t + j - 2; const bool ok = tt >= 0 && tt < M; const int tc = ok ? tt : t;
            u32x4 xv = *(const u32x4*)(proj + (size_t)tc * NIN + C_XR + blk * 128 + c0);
            if (!ok) xv = (u32x4){0u, 0u, 0u, 0u};
            const f32x4 w0 = *(const LAS f32x4*)(CWl + j * 128 + c0), w1 = *(const LAS f32x4*)(CWl + j * 128 + c0 + 4);
            acc0.x += w0.x * bflo(xv.x); acc0.y += w0.y * bfhi(xv.x); acc0.z += w0.z * bflo(xv.y); acc0.w += w0.w * bfhi(xv.y);
            acc1.x += w1.x * bflo(xv.z); acc1.y += w1.y * bfhi(xv.z); acc1.z += w1.z * bflo(xv.w); acc1.w += w1.w * bfhi(xv.w); }
        u32x4 o; o.x = pk2(acc0.x, acc0.y); o.y = pk2(acc0.z, acc0.w); o.z = pk2(acc1.x, acc1.y); o.w = pk2(acc1.z, acc1.w);
        A[kk] = __builtin_bit_cast(bf16x8, o); if ((kk & 3) == 3) asm volatile("" ::: "memory"); }
    bf16x8 Bid[2];
#pragma unroll
    for (int kq = 0; kq < 2; ++kq)
#pragma unroll
        for (int j = 0; j < 8; ++j) Bid[kq][j] = (16 * kq + 8 * hi + j == r32) ? (short)0x3F80 : (short)0;
    unsigned* hcout = (unsigned*)(ws + (d ? WS_HB : WS_HF));
#pragma unroll
    for (int rd = 0; rd < 4; ++rd) {
        float hl[1][16], cq[1][16];
#pragma unroll
        for (int cc = 0; cc < 1; ++cc) { const int ct = rd + cc;
            f32x16 accr = {}, acci = {}, accx = {};
#pragma unroll
            for (int kk = 0; kk < 8; ++kk) {
                const bf16x8 br = *(const LAS bf16x8*)(lds + L_WT + KSWZ_(ct * 32 + r32, (kk * 16 + hi * 8) * 2));
                const bf16x8 bi = *(const LAS bf16x8*)(lds + L_WT + KSWZ_(128 + ct * 32 + r32, (kk * 16 + hi * 8) * 2));
                accr = __builtin_amdgcn_mfma_f32_32x32x16_bf16(A[kk], br, accr, 0, 0, 0);
                acci = __builtin_amdgcn_mfma_f32_32x32x16_bf16(A[kk], bi, acci, 0, 0, 0);
            }
            accx = __builtin_amdgcn_mfma_f32_32x32x16_bf16(A[2 * ct], Bid[0], accx, 0, 0, 0);
            accx = __builtin_amdgcn_mfma_f32_32x32x16_bf16(A[2 * ct + 1], Bid[1], accx, 0, 0, 0);
            const int cidx = d * 1024 + blk * 128 + ct * 32 + r32;
            const float ba = a.in[I_BA][cidx], bx = a.in[I_BX][cidx], lam = a.in[I_LAM][cidx];
            const float sp8 = 8.f * log1pf(__expf(-lam));
            float av[16], bv[16];
#pragma unroll
            for (int r = 0; r < 16; ++r) {
                const float rg = __builtin_amdgcn_rcpf(1.f + __builtin_amdgcn_exp2f(-1.4426950408889634f * (accr[r] + ba)));
                const float ig = __builtin_amdgcn_rcpf(1.f + __builtin_amdgcn_exp2f(-1.4426950408889634f * (acci[r] + bx)));
                const float la = -sp8 * rg; const float aa = __builtin_amdgcn_exp2f(1.4426950408889634f * la);
                const float om = __builtin_fmaf(-aa, aa, 1.f);
                av[r] = aa; bv[r] = __builtin_amdgcn_sqrtf(om) * ig * accx[r];
            }
            float Pg[4], Hg[4];
#pragma unroll
            for (int g = 0; g < 4; ++g) { float h = 0.f, cp = 1.f;
#pragma unroll
                for (int e = 0; e < 4; ++e) { const int r = 4 * g + (DIR == 0 ? e : 3 - e); h = av[r] * h + bv[r]; cp *= av[r]; bv[r] = h; av[r] = cp; }
                Pg[g] = cp; Hg[g] = h; }
            float F = 1.f, E = 0.f, Fg[4], Eg[4];
#pragma unroll
            for (int gi = 0; gi < 4; ++gi) { const int g = DIR == 0 ? gi : 3 - gi;
                const float pP = __shfl_xor(Pg[g], 32), pH = __shfl_xor(Hg[g], 32);
                const float Pe = hi ? pP : Pg[g], He = hi ? pH : Hg[g];
                const float Po = hi ? Pg[g] : pP, Ho = hi ? Hg[g] : pH;
                if (DIR == 0) { const float F1 = Pe * F, E1 = Pe * E + He; Fg[g] = hi ? F1 : F; Eg[g] = hi ? E1 : E; F = Po * F1; E = Po * E1 + Ho; }
                else          { const float F1 = Po * F, E1 = Po * E + Ho; Fg[g] = hi ? F : F1; Eg[g] = hi ? E : E1; F = Pe * F1; E = Pe * E1 + He; } }
            if (hi == 0) { f32x2 o; o.x = F; o.y = E; SUM[(rd * 8 + w) * 32 + r32] = o; }
#pragma unroll
            for (int r = 0; r < 16; ++r) { hl[cc][r] = bv[r] + av[r] * Eg[r >> 2]; cq[cc][r] = av[r] * Fg[r >> 2]; }
        }
        __syncthreads();
        {
            const int ct = rd; float Fw = 1.f, Ew = 0.f;
            if (DIR == 0) { for (int wp = 0; wp < w; ++wp) { const f32x2 fe = SUM[(rd * 8 + wp) * 32 + r32]; Ew = fe.x * Ew + fe.y; Fw *= fe.x; } }
            else          { for (int wp = 7; wp > w; --wp) { const f32x2 fe = SUM[(rd * 8 + wp) * 32 + r32]; Ew = fe.x * Ew + fe.y; Fw *= fe.x; } }
            const size_t o0 = (size_t)(ck * 256 + w * 32) * LW + blk * 128 + ct * 32 + r32;
#pragma unroll
            for (int r = 0; r < 16; ++r) { const size_t oo = o0 + (size_t)crow_(r, hi) * LW;
                hcout[oo] = pk2(hl[0][r] + cq[0][r] * Ew, cq[0][r] * Fw); }
        }
        if (tid < 32) {
            float F = 1.f, E = 0.f;
#pragma unroll
            for (int wi = 0; wi < 8; ++wi) { const int wp = DIR == 0 ? wi : 7 - wi; const f32x2 fe = SUM[(rd * 8 + wp) * 32 + tid]; E = fe.x * E + fe.y; F *= fe.x; }
            f32x2 o; o.x = F; o.y = E; ((f32x2*)(ws + WS_SUMM))[(ck * 2 + d) * 1024 + blk * 128 + rd * 32 + tid] = o;
        }
    }
}
__device__ __forceinline__ void lru_phase(const Args& a, LAS unsigned char* lds, int bid, int G, int nrep) {
    const int key = bid & 15, d = key & 1, blk = key >> 1, ck0 = bid >> 4, dck = G >> 4;
    if (d == 0) { bool first = true; for (int c_ = ck0; c_ < 64 * nrep; c_ += dck) { lru_unit<0>(a, lds, c_ & 63, blk, first); first = false; } }
    else        { bool first = true; for (int c_ = ck0; c_ < 64 * nrep; c_ += dck) { lru_unit<1>(a, lds, c_ & 63, blk, first); first = false; } }
    __syncthreads();
}
__device__ __forceinline__ void carry_phase(const Args& a, int gw, int NGW, int lane) {
    const f32x2* summ = (const f32x2*)(a.ws + WS_SUMM); float* carry = (float*)(a.ws + WS_CARRY);
    for (int ch = gw; ch < 2048; ch += NGW) { const int d = ch >> 10, c = ch & 1023, kk = d ? 63 - lane : lane;
        const f32x2 s = summ[(kk * 2 + d) * 1024 + c]; float P = s.x, H = s.y;
#pragma unroll
        for (int off = 1; off < 64; off <<= 1) { const float Pp = __shfl_up(P, off), Hp = __shfl_up(H, off); if (lane >= off) { H = P * Hp + H; P = P * Pp; } }
        const float cin = __shfl_up(H, 1);
        carry[(kk * 2 + d) * 1024 + c] = lane ? cin : 0.f; }
}

__device__ __forceinline__ void p4_mix(const Args& a, int gw, int NGW, int lane) {
    unsigned char* ws = a.ws;
    const bf16r* proj = (const bf16r*)(ws + WS_PROJ); bf16r* mixed = (bf16r*)(ws + WS_XN);
    const float* O = (const float*)(ws + WS_O);
    const unsigned* HCF = (const unsigned*)(ws + WS_HF); const unsigned* HCB = (const unsigned*)(ws + WS_HB);
    const float* carry = (const float*)(ws + WS_CARRY);
    const f32x4* anw = (const f32x4*)a.in[I_ANW] + lane; const f32x4* lnw = (const f32x4*)a.in[I_LNW] + lane;
    for (int b8 = gw; b8 < M / 8; b8 += NGW) {
        const int ck = b8 >> 5; f32x4 cf[4], cb[4];
#pragma unroll
        for (int j = 0; j < 4; ++j) { cf[j] = ((const f32x4*)(carry + (ck * 2 + 0) * 1024) + lane)[64 * j]; cb[j] = ((const f32x4*)(carry + (ck * 2 + 1) * 1024) + lane)[64 * j]; }
        for (int rr = 0; rr < 8; ++rr) { const int m = b8 * 8 + rr;
        f32x4 v[4], u[4]; float s1 = 0.f, s2 = 0.f;
#pragma unroll
        for (int j = 0; j < 4; ++j) {
            v[j] = ((const f32x4*)(O + (size_t)m * AW) + lane)[64 * j];
            const u32x4 f = ((const u32x4*)(HCF + (size_t)m * LW) + lane)[64 * j], b = ((const u32x4*)(HCB + (size_t)m * LW) + lane)[64 * j];
            u[j].x = (bflo(f.x) + bfhi(f.x) * cf[j].x) + (bflo(b.x) + bfhi(b.x) * cb[j].x);
            u[j].y = (bflo(f.y) + bfhi(f.y) * cf[j].y) + (bflo(b.y) + bfhi(b.y) * cb[j].y);
            u[j].z = (bflo(f.z) + bfhi(f.z) * cf[j].z) + (bflo(b.z) + bfhi(b.z) * cb[j].z);
            u[j].w = (bflo(f.w) + bfhi(f.w) * cf[j].w) + (bflo(b.w) + bfhi(b.w) * cb[j].w);
            s1 += (v[j].x * v[j].x + v[j].y * v[j].y) + (v[j].z * v[j].z + v[j].w * v[j].w);
            s2 += (u[j].x * u[j].x + u[j].y * u[j].y) + (u[j].z * u[j].z + u[j].w * u[j].w); }
        const float r1 = rsqrtf(wave_sum(s1) * (1.f / AW) + EPS), r2 = rsqrtf(wave_sum(s2) * (1.f / LW) + EPS);
        const u32x2* ga = (const u32x2*)(proj + (size_t)m * NIN + C_GA) + lane; const u32x2* gl = (const u32x2*)(proj + (size_t)m * NIN + C_GL) + lane;
        u32x2* mo = (u32x2*)(mixed + (size_t)m * MIXW) + lane;
#pragma unroll
        for (int j = 0; j < 4; ++j) {
            { const u32x2 g = ga[64 * j]; const f32x4 w = anw[64 * j];
              const float g0 = bflo(g.x), g1 = bfhi(g.x), g2 = bflo(g.y), g3 = bfhi(g.y);
              u32x2 o; o.x = pk2(v[j].x * r1 * w.x * g0 * sigmoidf_(g0), v[j].y * r1 * w.y * g1 * sigmoidf_(g1));
              o.y = pk2(v[j].z * r1 * w.z * g2 * sigmoidf_(g2), v[j].w * r1 * w.w * g3 * sigmoidf_(g3)); mo[64 * j] = o; }
            { const u32x2 g = gl[64 * j]; const f32x4 w = lnw[64 * j];
              const float g0 = bflo(g.x), g1 = bfhi(g.x), g2 = bflo(g.y), g3 = bfhi(g.y);
              u32x2 o; o.x = pk2(u[j].x * r2 * w.x * g0 * sigmoidf_(g0), u[j].y * r2 * w.y * g1 * sigmoidf_(g1));
              o.y = pk2(u[j].z * r2 * w.z * g2 * sigmoidf_(g2), u[j].w * r2 * w.w * g3 * sigmoidf_(g3)); mo[256 + 64 * j] = o; }
        }
        }
    }
}

#define RLX_AGENT __ATOMIC_RELAXED, __HIP_MEMORY_SCOPE_AGENT
#define XB_TMO      128
#define XB_XCNT(j)  (256  + 64 * (j))
#define XB_XSUB(j)  (1280 + 64 * (j))
#define XB_XGEN(j)  (2304 + 64 * (j))
#define XB_TOP      3328
#define XB_TOPGEN   3392
#define XCD_BAR_WORDS 3456
#define XB_SPIN_CAP (1u << 18)

__device__ __forceinline__ unsigned xb_ld(unsigned* p)              { return __hip_atomic_load(p, __ATOMIC_RELAXED, __HIP_MEMORY_SCOPE_AGENT); }
__device__ __forceinline__ unsigned xb_add(unsigned* p, unsigned v) { return __hip_atomic_fetch_add(p, v, __ATOMIC_RELAXED, __HIP_MEMORY_SCOPE_AGENT); }
__device__ __forceinline__ unsigned xb_xcc_id() { return (unsigned)__builtin_amdgcn_s_getreg((3 << 11) | 20) & 0xFu; }
#define XB_SPIN(cond, bar) do { unsigned _sp = 0; while (cond) { __builtin_amdgcn_s_sleep(1); \
    if ((++_sp & 255u) == 0u) { if (xb_ld(&(bar)[XB_TMO])) break; if (_sp > XB_SPIN_CAP) { atomicAdd(&(bar)[XB_TMO], 1u); break; } } } } while (0)

struct XcdBarrier {
    unsigned* bar; unsigned x;
    volatile LAS unsigned* st;
};

__device__ __forceinline__ XcdBarrier xcd_barrier_post(unsigned* bar, volatile LAS unsigned* st) {
    XcdBarrier b; b.bar = bar; b.x = xb_xcc_id(); b.st = st;
    if (threadIdx.x == 0) (void)xb_add(&bar[XB_XCNT(b.x)], 1u);
    return b;
}
__device__ __forceinline__ void xcd_barrier_complete(unsigned* bar, unsigned x, unsigned& nloc, unsigned& nx) {
    const unsigned G = gridDim.x * gridDim.y * gridDim.z;
    unsigned sum, cnt, mine, sp = 0u;
    for (;;) {
        sum = 0u; cnt = 0u; mine = 0u;
#pragma unroll
        for (unsigned j = 0; j < 16; ++j) { const unsigned c = xb_ld(&bar[XB_XCNT(j)]); sum += c; cnt += (c > 0u) ? 1u : 0u; mine = (j == x) ? c : mine; }
        if (sum == G) break;
        __builtin_amdgcn_s_sleep(1);
        if ((++sp & 255u) == 0u) { if (xb_ld(&bar[XB_TMO])) break; if (sp > XB_SPIN_CAP) { atomicAdd(&bar[XB_TMO], 1u); break; } }
    }
    nloc = mine > 0u ? mine : 1u; nx = cnt > 0u ? cnt : 1u;
}

__device__ __forceinline__ void xcd_barrier(const XcdBarrier& b) {
    asm volatile("s_waitcnt vmcnt(0)" ::: "memory");
    __syncthreads();
    if (threadIdx.x == 0) {
        unsigned* bar = b.bar;
        __builtin_amdgcn_s_waitcnt(0);
        unsigned nloc = b.st[0], nx = b.st[1];
        if (nloc == 0u) { xcd_barrier_complete(bar, b.x, nloc, nx); b.st[0] = nloc; b.st[1] = nx; }
        const unsigned old = xb_add(&bar[XB_XSUB(b.x)], 1u);
        const unsigned gen = old / nloc;
        if (old + 1u == (gen + 1u) * nloc) {
            __builtin_amdgcn_fence(__ATOMIC_RELEASE, "agent");
            asm volatile("s_waitcnt vmcnt(0)" ::: "memory");
            const unsigned og = xb_add(&bar[XB_TOP], 1u);
            const unsigned tg = og / nx;
            if (og + 1u == (tg + 1u) * nx) xb_add(&bar[XB_TOPGEN], 1u);
            else XB_SPIN(xb_ld(&bar[XB_TOPGEN]) == tg, bar);
            __builtin_amdgcn_fence(__ATOMIC_ACQUIRE, "agent");
            xb_add(&bar[XB_XGEN(b.x)], 1u);
            asm volatile("s_waitcnt vmcnt(0)" ::: "memory");
        } else {
            XB_SPIN(xb_ld(&bar[XB_XGEN(b.x)]) == gen, bar);
            __builtin_amdgcn_fence(__ATOMIC_ACQUIRE, "agent");
            asm volatile("s_waitcnt vmcnt(0)" ::: "memory");
        }
    }
    __syncthreads();
}

__global__ void __launch_bounds__(NTHREADS) hybrid_fwd(Args args) {
    extern __shared__ __attribute__((aligned(16))) unsigned char lds_raw[];
    LAS unsigned char* lds = (LAS unsigned char*)lds_raw;
    __shared__ __attribute__((aligned(16))) unsigned xb_st[4];
    cg::grid_group grid = cg::this_grid();
    const int tid = threadIdx.x, lane = tid & 63, wave = __builtin_amdgcn_readfirstlane(tid >> 6);
    if (tid < 4) xb_st[tid] = 0u;
    __syncthreads();
    const XcdBarrier xbar = xcd_barrier_post((unsigned*)args.ws, (volatile LAS unsigned*)xb_st);
    const int G = gridDim.x, bid = blockIdx.x;
    const int gw = bid * NWAVES + wave, NGW = G * NWAVES;
    unsigned char* ws = args.ws;
    const int lo = args.ph_lo, hi = args.ph_hi;
#define IN(k) (lo <= (k) && (k) < hi)
#ifndef REP
#define REP -1
#endif
#define NREP(k) ((REP) == (k) ? 2 : 1)
#define SEAM(k) do { if (IN(k) && IN((k) + 1)) xcd_barrier(xbar); } while (0)
    if (lo > hi) grid.sync();

    if (IN(0)) { p0_prologue(args, lds, gw, NGW, lane, wave); __syncthreads(); }
    SEAM(0);
    if (IN(1)) {
        pg8::Gemm g{(const pg8::bf16_t*)(ws + WS_XN), (const pg8::bf16_t*)(ws + WS_WIN), M, NIN, DM}; pg8::StaticOrder S; S.init(M, NIN, G, bid);
        pg8::EpiStoreBf16 E{(pg8::bf16_t*)(ws + WS_PROJ), NIN};
        pg8::gemm_phase<pg8::EpiStoreBf16, pg8::StaticOrder, true, true>(lds, g, S, E);
        __syncthreads();
    }
    SEAM(1);
    if (IN(2)) p2_qkprep(args, gw, NGW, lane);
    SEAM(2);
    if (IN(3)) {
        const att::bf16* proj = (const att::bf16*)(ws + WS_PROJ);
        for (int u = bid; u < 512; u += G) { const int h = u >> 6, qb = u & 63, kvh = h >> 2;
            att::attn_dense_body<att::bf16>(proj + (size_t)qb * 256 * NIN + C_Q + h * 128, proj + C_K + kvh * 128, proj + C_V + kvh * 128,
                                            (float*)(ws + WS_O) + (size_t)qb * 256 * AW + h * 128, M, (char*)lds_raw, args.in[I_QNW], args.in[I_KNW], (const float*)(ws + WS_TAB), qb * 256);
            __syncthreads(); }
        lru_phase(args, lds, bid, G, 1);
    }
    SEAM(3);
    if (IN(4)) carry_phase(args, gw, NGW, lane);
    SEAM(4);
    if (IN(5)) p4_mix(args, gw, NGW, lane);
    SEAM(5);
    if (IN(6)) {
        pg8::Gemm g{(const pg8::bf16_t*)(ws + WS_XN), (const pg8::bf16_t*)(ws + WS_WOUT), M, DM, MIXW}; pg8::StaticOrder S; S.init(M, DM, G, bid);
        pg8::EpiResidual E{args.in[I_X], args.out, DM};
        pg8::gemm_phase<pg8::EpiResidual, pg8::StaticOrder, true, true>(lds, g, S, E);
    }
#undef IN
#undef SEAM
}

#ifndef N_LAUNCHES
#define N_LAUNCHES 1
#endif
extern "C" void kernel_launch(void* const* d_in, const int* in_sizes, int n_in, void* d_out, int out_size, void* d_ws, size_t ws_size, hipStream_t stream) {
    static int grid = 0;
    if (grid == 0) {
        if (n_in != 15 || in_sizes[0] != M * DM || out_size != M * DM || ws_size < WS_END) { fprintf(stderr, "kernel_launch: shape/workspace mismatch (n_in %d, ws %zu)\n", n_in, ws_size); grid = -1; return; }
        int dev = 0, cus = 0, per_cu = 0;
        (void)hipGetDevice(&dev); (void)hipDeviceGetAttribute(&cus, hipDeviceAttributeMultiprocessorCount, dev);
        if (hipFuncSetAttribute((const void*)hybrid_fwd, hipFuncAttributeMaxDynamicSharedMemorySize, LDS_BYTES) != hipSuccess) { fprintf(stderr, "kernel_launch: hipFuncSetAttribute failed\n"); grid = -1; return; }
        if (hipOccupancyMaxActiveBlocksPerMultiprocessor(&per_cu, (const void*)hybrid_fwd, NTHREADS, LDS_BYTES) != hipSuccess || per_cu < 1) { fprintf(stderr, "kernel_launch: occupancy query gave %d\n", per_cu); per_cu = 1; }
        (void)hipGetLastError();
        grid = cus * 1;
    }
    if (grid < 0) return;
    Args a{};
    for (int i = 0; i < 15; ++i) a.in[i] = (const float*)d_in[i];
    a.out = (float*)d_out; a.ws = (unsigned char*)d_ws;
    if (hipMemsetAsync(d_ws, 0, 16384, stream) != hipSuccess) { fprintf(stderr, "kernel_launch: hipMemsetAsync failed\n"); return; }
    if (N_LAUNCHES == 1) {
        a.ph_lo = 0; a.ph_hi = 7;
        void* kargs[] = {&a};
        hipError_t e = hipLaunchCooperativeKernel((const void*)hybrid_fwd, dim3(grid), dim3(NTHREADS), kargs, LDS_BYTES, stream);
        if (e != hipSuccess) fprintf(stderr, "cooperative launch failed: %s (grid %d)\n", hipGetErrorString(e), grid);
    } else {
        for (int p = 0; p < 7; ++p) { a.ph_lo = p; a.ph_hi = p + 1; hipLaunchKernelGGL(hybrid_fwd, dim3(grid), dim3(NTHREADS), LDS_BYTES, stream, a); }
    }
}
```

```cpp
#include <hip/hip_runtime.h>
#include <hip/hip_bf16.h>
#include <hip/hip_cooperative_groups.h>
#include <cstdio>
#include <cstdint>
namespace cg = cooperative_groups;
namespace pg8 {
#define PG8_LAS __attribute__((address_space(3)))
typedef unsigned short bf16_t;
typedef short bf16x8 __attribute__((ext_vector_type(8)));
typedef float f32x4 __attribute__((ext_vector_type(4)));
typedef unsigned u32x4 __attribute__((ext_vector_type(4)));
constexpr int BM = 256, BK = 64, HALF = 128, HTB = HALF * BK * 2  , STAGE_BYTES = 8 * HTB, NXCD = 8, WGM = 8;

__host__ __device__ __forceinline__ int lds_byte(int r, int c) { const int st = (r >> 4) * 2 + (c >> 5), rr = r & 15, cc = c & 31, ob = rr * 64 + cc * 2; return st * 1024 + (ob ^ (((ob >> 9) & 1) << 5)); }
__host__ __device__ __forceinline__ void stage_rc(int b, int& R, int& C) { const int st = b / 1024, sb = b % 1024, swz = sb ^ (((sb >> 9) & 1) << 5); R = (st >> 1) * 16 + swz / 64; C = (st & 1) * 32 + (swz % 64) / 2; }
__host__ __device__ __forceinline__ int perm32(int rho) { const int n = rho >> 4, i = rho & 15; return 8 * (i >> 2) + 4 * n + (i & 3); }

struct Unit { int pm, pn; };
struct Gemm { const bf16_t* A; const bf16_t* Bt; int M, N, K; };

struct StaticOrder {
    int nM, nN, nwg, G, c;
    __host__ __device__ void init(int M, int N, int G_, int c_) { nM = M / BM; nN = N / BM; nwg = nM * nN; G = G_; c = c_; }
    __host__ __device__ bool next(int i, Unit& u) const {
        const long L = (long)i * G + c; if (L >= nwg) return false;
        int wgid = (int)L; { const int q = nwg / NXCD, r = nwg % NXCD, xcd = wgid % NXCD, off = wgid / NXCD; wgid = (xcd < r ? xcd * (q + 1) : r * (q + 1) + (xcd - r) * q) + off; }
        const int nig = WGM * nN, gid = wgid / nig, fm = gid * WGM, gsz = (nM - fm) < WGM ? (nM - fm) : WGM;
        u.pm = fm + ((wgid % nig) % gsz); u.pn = (wgid % nig) / gsz; return true;
    }
    __device__ __forceinline__ void a_ready(const Unit&) const {}
    __device__ __forceinline__ void done(const Unit&) const {}
};

__device__ __forceinline__ unsigned cvt_pk_bf16(float lo, float hi) { unsigned r; asm volatile("v_cvt_pk_bf16_f32 %0, %1, %2" : "=v"(r) : "v"(lo), "v"(hi)); return r; }
__device__ __forceinline__ void store16_wt(void* p, u32x4 v) { asm volatile("global_store_dwordx4 %0, %1, off sc1" :: "v"(p), "v"(v) : "memory"); }
struct EpiStoreBf16 {
    static constexpr bool PERM = true, AFTER_DRAIN = false;
    bf16_t* O; int ldc;
    __device__ __forceinline__ void operator()(const f32x4 (&acc)[2][2][4][2], const Unit& u, int wr, int wc, int fr, int fq) const {
        const int row0 = u.pm * BM + wr * 64 + fr; const int col0 = u.pn * BM + wc * 32 + 8 * fq;
#pragma unroll
        for (int ai = 0; ai < 2; ++ai)
#pragma unroll
            for (int m = 0; m < 4; ++m) { bf16_t* rowp = O + (size_t)(row0 + ai * HALF + m * 16) * ldc + col0;
#pragma unroll
                for (int bj = 0; bj < 2; ++bj) { const f32x4 v0 = acc[ai][bj][m][0], v1 = acc[ai][bj][m][1];
                    u32x4 w; w.x = cvt_pk_bf16(v0[0], v0[1]); w.y = cvt_pk_bf16(v0[2], v0[3]); w.z = cvt_pk_bf16(v1[0], v1[1]); w.w = cvt_pk_bf16(v1[2], v1[3]);
                    store16_wt(rowp + bj * HALF, w); } }
    }
};
struct EpiResidual {
    static constexpr bool PERM = false, AFTER_DRAIN = false;
    const float* x; float* out; int ldc;
    __device__ __forceinline__ void operator()(const f32x4 (&acc)[2][2][4][2], const Unit& u, int wr, int wc, int fr, int fq) const {
        const int row0 = u.pm * BM + wr * 64 + fr; const int col0 = u.pn * BM + wc * 32 + 4 * fq;
#pragma unroll
        for (int ai = 0; ai < 2; ++ai)
#pragma unroll
            for (int m = 0; m < 4; ++m) { const size_t off = (size_t)(row0 + ai * HALF + m * 16) * ldc + col0;
#pragma unroll
                for (int bj = 0; bj < 2; ++bj)
#pragma unroll
                    for (int n = 0; n < 2; ++n) { const f32x4 xv = *(const f32x4*)(x + off + bj * HALF + n * 16); *(f32x4*)(out + off + bj * HALF + n * 16) = xv + acc[ai][bj][m][n]; } }
    }
};
template <class Epi, class Sched, bool ALIGN_EPI = false, bool SP2 = false>
__device__ __forceinline__ void gemm_phase(PG8_LAS unsigned char* lds, const Gemm g, const Sched& S, const Epi& E) {
    const int tid = threadIdx.x, wid = __builtin_amdgcn_readfirstlane(tid >> 6), lane = tid & 63, wr = wid >> 2, wc = wid & 3, fr = lane & 15, fq = lane >> 4;
    const int K = g.K, nt = K / BK;
    unsigned voffA[2], voffB[2];
#pragma unroll
    for (int i = 0; i < 2; ++i) { int R, C; stage_rc(tid * 16 + i * 8192, R, C); const int Rb = Epi::PERM ? ((R & ~31) + perm32(R & 31)) : R;
        voffA[i] = (unsigned)(R * K + C) * 2u; voffB[i] = (unsigned)(Rb * K + C) * 2u; }
    const size_t kstep = (size_t)(BK * 2);
    const size_t hstep = (size_t)HALF * K * 2;
    const size_t tstep = 2 * hstep;
    const unsigned ldsw = (unsigned)wid * 1024u;
    const int aoff = lds_byte(wr * 64 + fr, fq * 8), boff = lds_byte(wc * 32 + fr, fq * 8);
#define PG8_SA(b, h) (((b) * 2 + (h)) * HTB)
#define PG8_SB(b, h) ((4 + (b) * 2 + (h)) * HTB)
#define PG8_STAGE(bufoff, gbase, voff) do { _Pragma("unroll") for (int _i = 0; _i < 2; ++_i) \
        __builtin_amdgcn_global_load_lds((const unsigned*)((const char*)(gbase) + (voff)[_i]), (PG8_LAS unsigned*)(lds + (bufoff) + ldsw + _i * 8192), 16, 0, 0); } while (0)
#define PG8_LDA(dst, b, h) do { _Pragma("unroll") for (int m = 0; m < 4; ++m) _Pragma("unroll") for (int k = 0; k < 2; ++k) dst[m][k] = *(const PG8_LAS bf16x8*)(lds + PG8_SA(b, h) + aoff + m * 2048 + k * 1024); } while (0)
#define PG8_LDB(dst, b, h) do { _Pragma("unroll") for (int n = 0; n < 2; ++n) _Pragma("unroll") for (int k = 0; k < 2; ++k) dst[n][k] = *(const PG8_LAS bf16x8*)(lds + PG8_SB(b, h) + boff + n * 2048 + k * 1024); } while (0)
#define PG8_MMA(ai, bj, At, Bt) do { __builtin_amdgcn_s_setprio(1); _Pragma("unroll") for (int m = 0; m < 4; ++m) _Pragma("unroll") for (int n = 0; n < 2; ++n) _Pragma("unroll") for (int k = 0; k < 2; ++k) \
        acc[ai][bj][m][n] = __builtin_amdgcn_mfma_f32_16x16x32_bf16(Bt[n][k], At[m][k], acc[ai][bj][m][n], 0, 0, 0); __builtin_amdgcn_s_setprio(0); } while (0)
#define PG8_WAIT_V(n) asm volatile("s_waitcnt vmcnt(" #n ")" ::: "memory")
#define PG8_WAIT_L(n) asm volatile("s_waitcnt lgkmcnt(" #n ")" ::: "memory")
#define PG8_BAR __builtin_amdgcn_s_barrier()
#define PG8_SCHED __builtin_amdgcn_sched_barrier(0)
    Unit cur, nxt; int ui = 0;
    if (!S.next(0, cur)) return;
    f32x4 acc[2][2][4][2];
#pragma unroll
    for (int a = 0; a < 2; ++a)
#pragma unroll
        for (int b = 0; b < 2; ++b)
#pragma unroll
            for (int m = 0; m < 4; ++m)
#pragma unroll
                for (int n = 0; n < 2; ++n) acc[a][b][m][n] = (f32x4){0.f, 0.f, 0.f, 0.f};
    bf16x8 At[4][2], B0[2][2], B1[2][2];
    const char* cA = (const char*)g.A + (size_t)cur.pm * tstep; const char* cB = (const char*)g.Bt + (size_t)cur.pn * tstep;
    S.a_ready(cur);
    if constexpr (SP2) {
        PG8_STAGE(PG8_SB(0, 0), cB, voffB); PG8_STAGE(PG8_SB(0, 1), cB + hstep, voffB); PG8_STAGE(PG8_SA(0, 0), cA, voffA); PG8_STAGE(PG8_SA(0, 1), cA + hstep, voffA);
        if (wr == 1) PG8_BAR;
        PG8_WAIT_V(2); PG8_BAR;
        PG8_STAGE(PG8_SB(1, 0), cB + kstep, voffB); PG8_STAGE(PG8_SA(1, 0), cA + kstep, voffA); PG8_STAGE(PG8_SB(1, 1), cB + hstep + kstep, voffB);
        PG8_WAIT_V(6); PG8_BAR;
    } else {
        PG8_STAGE(PG8_SB(0, 0), cB, voffB); PG8_STAGE(PG8_SA(0, 0), cA, voffA); PG8_STAGE(PG8_SB(0, 1), cB + hstep, voffB); PG8_STAGE(PG8_SA(0, 1), cA + hstep, voffA);
        if (wr == 1) PG8_BAR;
        PG8_WAIT_V(4); PG8_BAR;
        PG8_STAGE(PG8_SB(1, 0), cB + kstep, voffB); PG8_STAGE(PG8_SA(1, 0), cA + kstep, voffA); PG8_STAGE(PG8_SB(1, 1), cB + hstep + kstep, voffB);
        PG8_WAIT_V(6); PG8_BAR;
    }
    for (;;) {
        const bool has_next = S.next(ui + 1, nxt);
        const char* nA = has_next ? (const char*)g.A + (size_t)nxt.pm * tstep : cA; const char* nB = has_next ? (const char*)g.Bt + (size_t)nxt.pn * tstep : cB;
        for (int t = 0; t < nt; t += 2) {
            const bool last = (t == nt - 2);
            const char* a1 = cA + (size_t)(t + 1) * kstep;
            const char* a2 = last ? nA : cA + (size_t)(t + 2) * kstep; const char* b2 = last ? nB : cB + (size_t)(t + 2) * kstep;
            const char* a3 = a2 + kstep; const char* b3 = b2 + kstep;
            if (last && has_next) S.a_ready(nxt);
            if constexpr (SP2) {
            PG8_LDB(B0, 0, 0); PG8_LDB(B1, 0, 1); PG8_SCHED; PG8_LDA(At, 0, 0); PG8_STAGE(PG8_SA(1, 1), a1 + hstep, voffA);
            PG8_WAIT_V(8); PG8_WAIT_L(0); PG8_BAR; PG8_MMA(0, 0, At, B0); PG8_MMA(0, 1, At, B1); PG8_BAR; PG8_SCHED;
            PG8_LDA(At, 0, 1); PG8_STAGE(PG8_SB(0, 0), b2, voffB); PG8_STAGE(PG8_SB(0, 1), b2 + hstep, voffB); PG8_STAGE(PG8_SA(0, 0), a2, voffA);
            PG8_WAIT_V(8); PG8_WAIT_L(0); PG8_BAR; PG8_MMA(1, 0, At, B0); PG8_MMA(1, 1, At, B1); PG8_BAR; PG8_SCHED;
            PG8_LDB(B0, 1, 0); PG8_LDB(B1, 1, 1); PG8_SCHED; PG8_LDA(At, 1, 0); PG8_STAGE(PG8_SA(0, 1), a2 + hstep, voffA);
            PG8_WAIT_V(8); PG8_WAIT_L(0); PG8_BAR; PG8_MMA(0, 0, At, B0); PG8_MMA(0, 1, At, B1); PG8_BAR; PG8_SCHED;
            PG8_LDA(At, 1, 1); PG8_STAGE(PG8_SB(1, 0), b3, voffB); PG8_STAGE(PG8_SB(1, 1), b3 + hstep, voffB); PG8_STAGE(PG8_SA(1, 0), a3, voffA);
            PG8_WAIT_V(8); PG8_WAIT_L(0); PG8_BAR; PG8_MMA(1, 0, At, B0); PG8_MMA(1, 1, At, B1); PG8_BAR; PG8_SCHED;
            } else {
            PG8_LDB(B0, 0, 0); PG8_SCHED; PG8_LDA(At, 0, 0); PG8_STAGE(PG8_SA(1, 1), a1 + hstep, voffA);
            PG8_WAIT_L(8); PG8_BAR; PG8_WAIT_L(0); PG8_MMA(0, 0, At, B0); PG8_BAR; PG8_SCHED;
            PG8_LDB(B1, 0, 1); PG8_STAGE(PG8_SB(0, 0), b2, voffB);
            PG8_BAR; PG8_WAIT_L(0); PG8_MMA(0, 1, At, B1); PG8_BAR;
            PG8_LDA(At, 0, 1); PG8_STAGE(PG8_SA(0, 0), a2, voffA);
            PG8_BAR; PG8_WAIT_L(0); PG8_MMA(1, 0, At, B0); PG8_BAR; PG8_SCHED;
            PG8_STAGE(PG8_SB(0, 1), b2 + hstep, voffB);
            PG8_WAIT_V(6); PG8_BAR; PG8_MMA(1, 1, At, B1); PG8_BAR;
            PG8_LDB(B0, 1, 0); PG8_SCHED; PG8_LDA(At, 1, 0); PG8_STAGE(PG8_SA(0, 1), a2 + hstep, voffA);
            PG8_WAIT_L(8); PG8_BAR; PG8_WAIT_L(0); PG8_MMA(0, 0, At, B0); PG8_BAR; PG8_SCHED;
            PG8_LDB(B1, 1, 1); PG8_STAGE(PG8_SB(1, 0), b3, voffB);
            PG8_BAR; PG8_WAIT_L(0); PG8_MMA(0, 1, At, B1); PG8_BAR;
            PG8_LDA(At, 1, 1); PG8_STAGE(PG8_SA(1, 0), a3, voffA);
            PG8_BAR; PG8_WAIT_L(0); PG8_MMA(1, 0, At, B0); PG8_BAR; PG8_SCHED;
            PG8_STAGE(PG8_SB(1, 1), b3 + hstep, voffB);
            PG8_WAIT_V(6); PG8_BAR; PG8_MMA(1, 1, At, B1); PG8_BAR;
            }
        }
        if constexpr (ALIGN_EPI) { if (wr == 0) PG8_BAR; }
        if constexpr (!Epi::AFTER_DRAIN) { E(acc, cur, wr, wc, fr, fq); S.done(cur); }
        if (!has_next) break;
#pragma unroll
        for (int a = 0; a < 2; ++a)
#pragma unroll
            for (int b = 0; b < 2; ++b)
#pragma unroll
                for (int m = 0; m < 4; ++m)
#pragma unroll
                    for (int n = 0; n < 2; ++n) acc[a][b][m][n] = (f32x4){0.f, 0.f, 0.f, 0.f};
        cur = nxt; cA = nA; cB = nB; ++ui;
        if constexpr (ALIGN_EPI) { if (wr == 1) PG8_BAR; }
    }
    PG8_WAIT_V(0);
    if constexpr (!ALIGN_EPI) { if (wr == 0) PG8_BAR; }
    PG8_BAR;
    if constexpr (Epi::AFTER_DRAIN) { E.fused(acc, cur, wr, wc, fr, fq, lds, wid, lane); S.done(cur); }
#undef PG8_SA
#undef PG8_SB
#undef PG8_STAGE
#undef PG8_LDA
#undef PG8_LDB
#undef PG8_MMA
#undef PG8_WAIT_V
#undef PG8_WAIT_L
#undef PG8_BAR
#undef PG8_SCHED
}
}
namespace att {
using bf16 = __hip_bfloat16;
constexpr int   D = 128, NW = 8, QBLK = 32, KVBLK = 64;
constexpr float SCALE = 0.088388347648318440f;
constexpr float THR2 = 11.f;
constexpr float QSCALE = SCALE * 1.4426950408889634f;
constexpr int SDEPTH = 1;
constexpr int LDQ = 4608, LDK = 4608, LDO = 1024;
constexpr size_t SHM_V = KVBLK * D * 2, SHM_K = KVBLK * D * 2, SHM_ATTN = 2 * SHM_V + 2 * SHM_K + NW * 64 * 4;
using bf16x8 = __attribute__((ext_vector_type(8))) short;
using s16x4  = __attribute__((ext_vector_type(4))) short;
using f32x16 = __attribute__((ext_vector_type(16))) float;
using f32x8  = __attribute__((ext_vector_type(8))) float;
using u32x4  = __attribute__((ext_vector_type(4))) unsigned;
#define KSWZ(row, colB) ((row) * 256 + ((colB) ^ (((row) & 7) << 4)))
#define SBAR() __builtin_amdgcn_sched_barrier(0)
__device__ __forceinline__ int crow(int r, int hi) { return (r & 3) + 8 * (r >> 2) + 4 * hi; }
__device__ __forceinline__ unsigned cvtpk(float lo, float hi) {
  unsigned r; asm volatile("v_cvt_pk_bf16_f32 %0, %1, %2" : "=v"(r) : "v"(lo), "v"(hi)); return r;
}
template <typename TIn> struct Stage;
template <> struct Stage<bf16>  { using T = bf16x8;
  __device__ static __forceinline__ T ld8(const bf16* p) { return *reinterpret_cast<const bf16x8*>(p); }
  __device__ static __forceinline__ bf16x8 tobf(T x) { return x; } };
template <> struct Stage<float> { using T = f32x8;
  __device__ static __forceinline__ T ld8(const float* p) { return *reinterpret_cast<const f32x8*>(p); }
  __device__ static __forceinline__ bf16x8 tobf(T x) {
    u32x4 w = {cvtpk(x[0], x[1]), cvtpk(x[2], x[3]), cvtpk(x[4], x[5]), cvtpk(x[6], x[7])}; return *reinterpret_cast<bf16x8*>(&w); } };

__device__ __forceinline__ void partialSM(f32x16& p0) {
#pragma unroll
  for (int r = 0; r < 16; ++r) p0[r] = __builtin_amdgcn_exp2f(p0[r]);
}
__device__ __forceinline__ void finishSM(f32x16& p0, f32x16& p1, float& l_reg, bf16x8& pa0, bf16x8& pa1, bf16x8& pa2, bf16x8& pa3) {
  for (int r = 0; r < 16; ++r) p1[r] = __builtin_amdgcn_exp2f(p1[r]);
  float ps = 0; for (int r = 0; r < 16; ++r) ps += p0[r]; for (int r = 0; r < 16; ++r) ps += p1[r];
  { auto rr = __builtin_amdgcn_permlane32_swap(__float_as_uint(ps), __float_as_uint(ps), false, false);
    ps = __uint_as_float(rr[0]) + __uint_as_float(rr[1]); }
  l_reg += ps;
#define PK4(P, BASE, OUT) do { unsigned a0 = cvtpk(P[BASE + 0], P[BASE + 1]), a1 = cvtpk(P[BASE + 2], P[BASE + 3]);   \
    unsigned b0 = cvtpk(P[BASE + 4], P[BASE + 5]), b1 = cvtpk(P[BASE + 6], P[BASE + 7]);                              \
    auto r0 = __builtin_amdgcn_permlane32_swap(a0, b0, false, false); auto r1 = __builtin_amdgcn_permlane32_swap(a1, b1, false, false); \
    u32x4 w = {r0[0], r1[0], r0[1], r1[1]}; OUT = *reinterpret_cast<bf16x8*>(&w); } while (0)
  PK4(p0, 0, pa0); PK4(p0, 8, pa1); PK4(p1, 0, pa2); PK4(p1, 8, pa3);
#undef PK4
}
__device__ __forceinline__ void qkt(f32x16& p0, f32x16& p1, const bf16* Ks, const bf16x8* qr, const f32x16& negm, int r32, int hi) {
  const char* kb = (const char*)Ks + r32 * 32 + hi * 16;
#pragma unroll
  for (int d0 = 0; d0 < 8; ++d0) {
    bf16x8 b0 = *reinterpret_cast<const bf16x8*>(kb + d0 * 2048);
    bf16x8 b1 = *reinterpret_cast<const bf16x8*>(kb + d0 * 2048 + 1024);
    if (d0 == 0) { p0 = __builtin_amdgcn_mfma_f32_32x32x16_bf16(b0, qr[0], negm, 0, 0, 0); p1 = __builtin_amdgcn_mfma_f32_32x32x16_bf16(b1, qr[0], negm, 0, 0, 0); }
    else { p0 = __builtin_amdgcn_mfma_f32_32x32x16_bf16(b0, qr[d0], p0, 0, 0, 0); p1 = __builtin_amdgcn_mfma_f32_32x32x16_bf16(b1, qr[d0], p1, 0, 0, 0); } }
}
__device__ __forceinline__ int v_st(int k, int c) { const int kk = (k & ~0xC) | ((k & 4) << 1) | ((k & 8) >> 1); return ((kk >> 3) * 4 + (c >> 5)) * 512 + ((kk & 7) * 32 + (c & 31)) * 2; }
__device__ __forceinline__ int v_rd_base(int lane) { return ((lane & 3) << 3) | (((lane >> 2) & 3) << 6) | (((lane >> 4) & 1) << 5) | (((lane >> 5) & 1) << 8); }
constexpr int v_rd_off(int d0, int ks, int half) { return d0 * 512 + ks * 4096 + half * 2048; }
template <int OFF> __device__ __forceinline__ s16x4 tr_read(int vb) {
  s16x4 r; asm volatile("ds_read_b64_tr_b16 %0, %1 offset:%2" : "=&v"(r) : "v"(vb), "i"(OFF) : "memory"); return r;
}
template <int D0> __device__ __forceinline__ void pv_one(f32x16& od, int vb, bf16x8 pa0, bf16x8 pa1, bf16x8 pa2, bf16x8 pa3) {
  const s16x4 l0 = tr_read<v_rd_off(D0, 0, 0)>(vb), h0 = tr_read<v_rd_off(D0, 0, 1)>(vb), l1 = tr_read<v_rd_off(D0, 1, 0)>(vb), h1 = tr_read<v_rd_off(D0, 1, 1)>(vb);
  const s16x4 l2 = tr_read<v_rd_off(D0, 2, 0)>(vb), h2 = tr_read<v_rd_off(D0, 2, 1)>(vb), l3 = tr_read<v_rd_off(D0, 3, 0)>(vb), h3 = tr_read<v_rd_off(D0, 3, 1)>(vb);
  asm volatile("s_waitcnt lgkmcnt(0)" ::: "memory"); SBAR();
#define PK(L, H) (bf16x8){L[0], L[1], L[2], L[3], H[0], H[1], H[2], H[3]}
  od = __builtin_amdgcn_mfma_f32_32x32x16_bf16(pa0, PK(l0, h0), od, 0, 0, 0);
  od = __builtin_amdgcn_mfma_f32_32x32x16_bf16(pa1, PK(l1, h1), od, 0, 0, 0);
  od = __builtin_amdgcn_mfma_f32_32x32x16_bf16(pa2, PK(l2, h2), od, 0, 0, 0);
  od = __builtin_amdgcn_mfma_f32_32x32x16_bf16(pa3, PK(l3, h3), od, 0, 0, 0);
#undef PK
}
__device__ __forceinline__ void pv_d0(f32x16* o, int vb, bf16x8 pa0, bf16x8 pa1, bf16x8 pa2, bf16x8 pa3) {
  pv_one<0>(o[0], vb, pa0, pa1, pa2, pa3); pv_one<1>(o[1], vb, pa0, pa1, pa2, pa3); pv_one<2>(o[2], vb, pa0, pa1, pa2, pa3); pv_one<3>(o[3], vb, pa0, pa1, pa2, pa3);
}

template <typename TQ>
__device__ __forceinline__ void attn_dense_body(const TQ* __restrict__ Qb, const bf16* __restrict__ Kh, const bf16* __restrict__ Vh,
                                                float* __restrict__ Ob, int seq, char* lds, const float* __restrict__ qnw, const float* __restrict__ knw, const float* __restrict__ tab, int t0) {
  using SQ = Stage<TQ>;
  typedef __attribute__((address_space(3))) unsigned lds_u32;
  const int tid = threadIdx.x, lane = tid & 63, r32 = lane & 31, hi = lane >> 5;
  const int wid = __builtin_amdgcn_readfirstlane(tid >> 6);
  char* K_lds = lds; char* V_lds = lds + 4 * SHM_K;
  float* ws = (float*)(lds + 4 * SHM_V + 4 * SHM_K) + wid * 64; float* li_l = ws; float* al_l = ws + 32;
  float l_reg = 0; f32x16 o[4] = {}; bf16x8 qr[8]; f32x16 negm = {}; asm volatile("" : "+v"(negm));
  const TQ* Qw = Qb + (long)(wid * QBLK + r32) * LDQ + hi * 8;
  {
    const int t = t0 + wid * QBLK + r32; float x[8][8]; float ss = 0.f;
#pragma unroll
    for (int d0 = 0; d0 < 8; ++d0) { const u32x4 raw = *reinterpret_cast<const u32x4*>(Qw + d0 * 16);
#pragma unroll
      for (int k = 0; k < 4; ++k) { x[d0][2 * k] = __uint_as_float(raw[k] << 16); x[d0][2 * k + 1] = __uint_as_float(raw[k] & 0xffff0000u); ss += x[d0][2 * k] * x[d0][2 * k] + x[d0][2 * k + 1] * x[d0][2 * k + 1]; } }
    { auto rr = __builtin_amdgcn_permlane32_swap(__float_as_uint(ss), __float_as_uint(ss), false, false); ss = __uint_as_float(rr[0]) + __uint_as_float(rr[1]); }
    const float rstd = rsqrtf(ss * (1.f / 128.f) + 1e-6f); float n2 = 0.f;
#pragma unroll
    for (int d0 = 0; d0 < 8; ++d0) { const float* wp = qnw + d0 * 16 + hi * 8;
#pragma unroll
      for (int e = 0; e < 8; ++e) { x[d0][e] *= rstd * wp[e]; n2 += x[d0][e] * x[d0][e]; } }
    { auto rr = __builtin_amdgcn_permlane32_swap(__float_as_uint(n2), __float_as_uint(n2), false, false); n2 = __uint_as_float(rr[0]) + __uint_as_float(rr[1]); }
    float kwm = fmaxf(fabsf(knw[2 * lane]), fabsf(knw[2 * lane + 1]));
#pragma unroll
    for (int o_ = 1; o_ < 64; o_ <<= 1) kwm = fmaxf(kwm, __shfl_xor(kwm, o_));
    const float mref = fminf(sqrtf(n2) * QSCALE * 11.313708499f * kwm * 1.0005f, 60.f);
#pragma unroll
    for (int r = 0; r < 16; ++r) negm[r] = -mref;
    asm volatile("" : "+v"(negm));
#pragma unroll
    for (int half = 0; half < 2; ++half) { const int pos = half ? (t & 63) : (t >> 6);
#pragma unroll
      for (int b = 0; b < 2; ++b) { const float* tp = tab + (pos * 32 + b * 16 + hi * 8) * 2;
#pragma unroll
        for (int e = 0; e < 8; ++e) { const float c = tp[2 * e], sn = tp[2 * e + 1]; const float x1 = x[half * 4 + b][e], x2 = x[half * 4 + b + 2][e];
          x[half * 4 + b][e] = (x1 * c - x2 * sn) * QSCALE; x[half * 4 + b + 2][e] = (x2 * c + x1 * sn) * QSCALE; } } }
#pragma unroll
    for (int d0 = 0; d0 < 8; ++d0) { u32x4 w = {cvtpk(x[d0][0], x[d0][1]), cvtpk(x[d0][2], x[d0][3]), cvtpk(x[d0][4], x[d0][5]), cvtpk(x[d0][6], x[d0][7])}; qr[d0] = *reinterpret_cast<bf16x8*>(&w); }
  }
  const int vb0 = (int)(uintptr_t)V_lds + v_rd_base(lane);
  unsigned koff, voff;
  { const int d0 = wid >> 1, row = (wid & 1) * 32 + (lane >> 1), h_ = lane & 1; koff = (unsigned)(row * LDK + d0 * 16 + h_ * 8) * 2u; }
  { const int sub = wid * 2 + (lane >> 5), kk = (sub >> 2) * 8 + ((lane & 31) >> 2), c = (sub & 3) * 32 + (lane & 3) * 8;
    const int k = (kk & ~0xC) | ((kk & 4) << 1) | ((kk & 8) >> 1); voff = (unsigned)(k * LDK + c) * 2u; }
  const __attribute__((address_space(3))) char* kdst = (const __attribute__((address_space(3))) char*)(unsigned)(uintptr_t)(K_lds + wid * 1024);
  const __attribute__((address_space(3))) char* vdst = (const __attribute__((address_space(3))) char*)(unsigned)(uintptr_t)(V_lds + wid * 1024);
#define DMA(k0, off) do { const char* kt_ = (const char*)Kh + (size_t)(k0) * (LDK * 2); const char* vt_ = (const char*)Vh + (size_t)(k0) * (LDK * 2); \
      __builtin_amdgcn_global_load_lds((const unsigned*)(kt_ + koff), (lds_u32*)(kdst + (off)), 16, 0, 0); \
      __builtin_amdgcn_global_load_lds((const unsigned*)(kt_ + 128 + koff), (lds_u32*)(kdst + (off) + 8192), 16, 0, 0); \
      __builtin_amdgcn_global_load_lds((const unsigned*)(vt_ + voff), (lds_u32*)(vdst + (off)), 16, 0, 0); \
      __builtin_amdgcn_global_load_lds((const unsigned*)(vt_ + 32 * LDK * 2 + voff), (lds_u32*)(vdst + (off) + 8192), 16, 0, 0); } while (0)
#define VWAIT() asm volatile("s_waitcnt vmcnt(0)" ::: "memory")
#define ROT() do { const int t_ = sl_prev; sl_prev = sl_cur; sl_cur = sl_n1; sl_n1 = sl_n2; sl_n2 = t_; } while (0)
#define WAITBAR(N) asm volatile("s_waitcnt vmcnt(" #N ") lgkmcnt(0)\n\ts_barrier" ::: "memory")
  f32x16 pA0, pA1, pB0, pB1; bf16x8 pa0, pa1, pa2, pa3; const int NT = seq / KVBLK;
  DMA(0, 0); DMA(KVBLK, (int)SHM_K); DMA(2 * KVBLK, 2 * (int)SHM_K); WAITBAR(4);
  qkt(pA0, pA1, (const bf16*)K_lds, qr, negm, r32, hi); partialSM(pA0);
  int sl_prev = 0, sl_cur = (int)SHM_K, sl_n1 = 2 * (int)SHM_K, sl_n2 = 3 * (int)SHM_K;
#define STEP(PC0, PC1, PP0, PP1, LD, jn2) do { \
    if (LD) { DMA((jn2) * KVBLK, sl_n2); } SBAR(); \
    qkt(PC0, PC1, (const bf16*)(K_lds + sl_cur), qr, negm, r32, hi); \
    finishSM(PP0, PP1, l_reg, pa0, pa1, pa2, pa3); SBAR(); \
    pv_d0(o, vb0 + sl_prev, pa0, pa1, pa2, pa3); partialSM(PC0); \
    if (LD) { WAITBAR(4); } else { WAITBAR(0); } ROT(); } while (0)
  int j = 1;
  for (; j + 4 < NT; j += 2) {
    STEP(pB0, pB1, pA0, pA1, true, j + 2);
    STEP(pA0, pA1, pB0, pB1, true, j + 3);
  }
  STEP(pB0, pB1, pA0, pA1, true, j + 2);
  STEP(pA0, pA1, pB0, pB1, false, 0);
  STEP(pB0, pB1, pA0, pA1, false, 0);
  finishSM(pB0, pB1, l_reg, pa0, pa1, pa2, pa3); SBAR();
  pv_d0(o, vb0 + sl_prev, pa0, pa1, pa2, pa3);
  if (hi == 0) li_l[r32] = l_reg; asm volatile("s_waitcnt lgkmcnt(0)" ::: "memory");
  float rli[16];
#pragma unroll
  for (int r = 0; r < 16; ++r) rli[r] = __builtin_amdgcn_rcpf(li_l[crow(r, hi)]);
  float* Ow = Ob + (long)(wid * QBLK) * LDO;
#pragma unroll
  for (int r = 0; r < 16; ++r) { int orow = crow(r, hi);
    for (int d0 = 0; d0 < 4; ++d0) Ow[(long)orow * LDO + d0 * 32 + r32] = o[d0][r] * rli[r]; }
#undef DMA
#undef VWAIT
#undef ROT
#undef WAITBAR
#undef STEP
}
#undef KSWZ
#undef SBAR
}
constexpr int M = 16384, DM = 2048, NIN = 4608, AW = 1024, LW = 1024, MIXW = 2048;
constexpr int C_Q = 0, C_K = 1024, C_V = 1280, C_GA = 1536, C_XR = 2560, C_GL = 3584;
constexpr float EPS = 1e-6f;
constexpr int NTHREADS = 512, NWAVES = 8;
constexpr int LDS_BYTES = 135168;
constexpr size_t MiB = 1u << 20;
constexpr size_t WS_WIN = 2 * MiB;
constexpr size_t WS_WOUT = 20 * MiB;
constexpr size_t WS_WG = 28 * MiB;
constexpr size_t WS_TAB = 29 * MiB;
constexpr size_t WS_CARRY = 31 * MiB;
constexpr size_t WS_SUMM = 30 * MiB;
constexpr size_t WS_XN = 32 * MiB;
constexpr size_t WS_PROJ = 96 * MiB;
constexpr size_t WS_O = 240 * MiB;
constexpr size_t WS_HF = 304 * MiB;
constexpr size_t WS_HB = 368 * MiB;
constexpr size_t WS_END = 432 * MiB;

#define LAS __attribute__((address_space(3)))
typedef unsigned short bf16r;
typedef float f32x4 __attribute__((ext_vector_type(4)));
typedef float f32x2 __attribute__((ext_vector_type(2)));
typedef float f32x16 __attribute__((ext_vector_type(16)));
typedef unsigned u32x4 __attribute__((ext_vector_type(4)));
typedef unsigned u32x2 __attribute__((ext_vector_type(2)));
typedef short bf16x8 __attribute__((ext_vector_type(8)));

__device__ __forceinline__ unsigned pk2(float lo, float hi) { unsigned r; asm volatile("v_cvt_pk_bf16_f32 %0, %1, %2" : "=v"(r) : "v"(lo), "v"(hi)); return r; }
__device__ __forceinline__ float bflo(unsigned v) { return __uint_as_float(v << 16); }
__device__ __forceinline__ float bfhi(unsigned v) { return __uint_as_float(v & 0xffff0000u); }
__device__ __forceinline__ float wave_sum(float v) {
#pragma unroll
    for (int o = 1; o < 64; o <<= 1) v += __shfl_xor(v, o);
    return v;
}
__device__ __forceinline__ float sigmoidf_(float z) { return __builtin_amdgcn_rcpf(1.f + __expf(-z)); }

struct Args { const float* in[15]; float* out; unsigned char* ws; int ph_lo, ph_hi; };
enum { I_X = 0, I_NORMW, I_WIN, I_QNW, I_KNW, I_CONVW, I_CONVB, I_WA, I_BA, I_WX, I_BX, I_LAM, I_ANW, I_LNW, I_WOUT };

__device__ __forceinline__ void transpose_item(const float* W, int ldw, int nblk, bf16r* WT, int ldo, LAS float* scr, int item, int lane) {
    const int kb = item / nblk, nb = item % nblk, k0 = 64 * kb, n0 = 32 * nb;
#pragma unroll 8
    for (int i = 0; i < 32; ++i) { const int kk = 2 * i + (lane >> 5); scr[kk * 33 + (lane & 31)] = W[(size_t)(k0 + kk) * ldw + n0 + (lane & 31)]; }
    asm volatile("s_waitcnt lgkmcnt(0)" ::: "memory");
    const int c = lane & 7;
#pragma unroll
    for (int j = 0; j < 4; ++j) { const int n = (lane >> 3) + 8 * j; const LAS float* s = scr + (8 * c) * 33 + n;
        u32x4 o; o.x = pk2(s[0 * 33], s[1 * 33]); o.y = pk2(s[2 * 33], s[3 * 33]); o.z = pk2(s[4 * 33], s[5 * 33]); o.w = pk2(s[6 * 33], s[7 * 33]);
        *(u32x4*)(WT + (size_t)(n0 + n) * ldo + k0 + 8 * c) = o; }
    asm volatile("s_waitcnt lgkmcnt(0)" ::: "memory");
}
__device__ __forceinline__ void p0_prologue(const Args& a, LAS unsigned char* lds, int gw, int NGW, int lane, int wave) {
    unsigned char* ws = a.ws;
    LAS float* scr = (LAS float*)(lds + wave * 16384);
    constexpr int I_IN = (DM / 64) * (NIN / 32), I_OUT = (MIXW / 64) * (DM / 32), I_G = 32 * 8;
    for (int it = gw; it < I_IN + I_OUT + I_G; it += NGW) {
        if (it < I_IN) transpose_item(a.in[I_WIN], NIN, NIN / 32, (bf16r*)(ws + WS_WIN), DM, scr, it, lane);
        else if (it < I_IN + I_OUT) transpose_item(a.in[I_WOUT], DM, DM / 32, (bf16r*)(ws + WS_WOUT), MIXW, scr, it - I_IN, lane);
        else { const int r = it - I_IN - I_OUT, mat = r >> 3, sub = r & 7, which = mat >> 4, db = mat & 15;
            const float* src = (which ? a.in[I_WX] : a.in[I_WA]) + (size_t)db * 128 * 128;
            bf16r* dst = (bf16r*)(ws + WS_WG) + (size_t)db * 256 * 128 + (size_t)which * 128 * 128;
            transpose_item(src, 128, 4, dst, 128, scr, sub, lane); }
    }
    { const int e = gw * 64 + lane;
      if (e < 256 * 32) { const int pos = e >> 5, i = e & 31;
        const float invf = __builtin_amdgcn_exp2f(-(float)i * 0.41524101186092029f);
        const float ang = (float)pos * invf;
        const double ad = (double)ang; const double k = __builtin_rint(ad * 0.63661977236758134);
        const double r = __builtin_fma(-k, 1.5707963267948966, ad); const double r2 = r * r;
        const double sn = r * (1.0 + r2 * (-1.0 / 6 + r2 * (1.0 / 120 + r2 * (-1.0 / 5040 + r2 * (1.0 / 362880 + r2 * (-1.0 / 39916800))))));
        const double cs = 1.0 + r2 * (-0.5 + r2 * (1.0 / 24 + r2 * (-1.0 / 720 + r2 * (1.0 / 40320 + r2 * (-1.0 / 3628800 + r2 * (1.0 / 479001600))))));
        const int q = ((int)k) & 3;
        const double c_ = (q == 0) ? cs : (q == 1) ? -sn : (q == 2) ? -cs : sn;
        const double s_ = (q == 0) ? sn : (q == 1) ? cs : (q == 2) ? -sn : -cs;
        f32x2 o; o.x = (float)c_; o.y = (float)s_; ((f32x2*)(ws + WS_TAB))[e] = o; } }
    const float* x = a.in[I_X]; const f32x4* nw = (const f32x4*)a.in[I_NORMW] + lane;
    for (int m = gw; m < M; m += NGW) {
        const f32x4* xr = (const f32x4*)(x + (size_t)m * DM) + lane; f32x4 v[8]; float s = 0.f;
#pragma unroll
        for (int j = 0; j < 8; ++j) { v[j] = __builtin_nontemporal_load(xr + 64 * j); s += (v[j].x * v[j].x + v[j].y * v[j].y) + (v[j].z * v[j].z + v[j].w * v[j].w); }
        const float rstd = rsqrtf(wave_sum(s) * (1.f / DM) + EPS);
        u32x2* o8 = (u32x2*)((bf16r*)(ws + WS_XN) + (size_t)m * DM) + lane;
#pragma unroll
        for (int j = 0; j < 8; ++j) { const f32x4 w = nw[64 * j]; u32x2 o; o.x = pk2(v[j].x * rstd * w.x, v[j].y * rstd * w.y); o.y = pk2(v[j].z * rstd * w.z, v[j].w * rstd * w.w); o8[64 * j] = o; }
    }
}

__device__ __forceinline__ void p2_qkprep(const Args& a, int gw, int NGW, int lane) {
    bf16r* proj = (bf16r*)(a.ws + WS_PROJ); const float* tab = (const float*)(a.ws + WS_TAB);
    const f32x2 kw = ((const f32x2*)a.in[I_KNW])[lane];
    const int i0 = (2 * lane) & 31; const float sgn = (lane & 16) ? 1.f : -1.f;
    for (int t0 = gw; t0 < M; t0 += 4 * NGW) {
        unsigned v[4][2]; f32x4 cs[4]; unsigned* rowp[4];
#pragma unroll
        for (int q = 0; q < 4; ++q) { const int t = min(t0 + q * NGW, M - 1); const int pos = (lane < 32) ? (t >> 6) : (t & 63);
            cs[q] = *(const f32x4*)(tab + (pos * 32 + i0) * 2);
            rowp[q] = (unsigned*)(proj + (size_t)t * NIN + C_K) + lane; v[q][0] = rowp[q][0]; v[q][1] = rowp[q][64]; }
#pragma unroll
        for (int q = 0; q < 4; ++q) { if (t0 + q * NGW >= M) break;
#pragma unroll
            for (int hh = 0; hh < 2; ++hh) {
                const float x0 = bflo(v[q][hh]), x1 = bfhi(v[q][hh]);
                const float rstd = rsqrtf(wave_sum(x0 * x0 + x1 * x1) * (1.f / 128.f) + EPS);
                const float y0 = x0 * rstd * kw.x, y1 = x1 * rstd * kw.y;
                const float p0 = __shfl_xor(y0, 16), p1 = __shfl_xor(y1, 16);
                rowp[q][hh * 64] = pk2(y0 * cs[q].x + sgn * p0 * cs[q].y, y1 * cs[q].z + sgn * p1 * cs[q].w); } }
    }
}

constexpr int L_SUM = 0, L_CW = 8192, L_WT = 16384;
#define KSWZ_(row, colB) ((row) * 256 + ((colB) ^ (((row) & 7) << 4)))
__device__ __forceinline__ int crow_(int r, int hi) { return (r & 3) + 8 * (r >> 2) + 4 * hi; }
template <int DIR>
__device__ __forceinline__ void lru_unit(const Args& a, LAS unsigned char* lds, int ck, int blk, bool load_w) {
    int tid = threadIdx.x; asm volatile("" : "+v"(tid));
    const int lane = tid & 63, r32 = lane & 31, hi = lane >> 5;
    const int w = __builtin_amdgcn_readfirstlane(tid >> 6);
    constexpr int d = DIR;
    unsigned char* ws = a.ws;
    const bf16r* proj = (const bf16r*)(ws + WS_PROJ);
    LAS float* CWl = (LAS float*)(lds + L_CW);
    LAS f32x2* SUM = (LAS f32x2*)(lds + L_SUM);
    __syncthreads();
    if (load_w) {
        const bf16r* Wt = (const bf16r*)(ws + WS_WG) + (size_t)(d * 8 + blk) * 256 * 128;
#pragma unroll
        for (int i = 0; i < 8; ++i) { const int p = tid + 512 * i, row = p >> 4, c16 = p & 15;
            const u32x4 v = *(const u32x4*)(Wt + row * 128 + c16 * 8); *(LAS u32x4*)(lds + L_WT + KSWZ_(row, c16 * 16)) = v; }
        const float* cw = a.in[I_CONVW]; const float* cbias = a.in[I_CONVB];
        for (int e = tid; e < 640; e += 512) CWl[e] = e < 512 ? cw[(e >> 7) * 1024 + blk * 128 + (e & 127)] : cbias[blk * 128 + (e - 512)];
    }
    __syncthreads();
    const int t = ck * 256 + w * 32 + r32;
    bf16x8 A[8];
#pragma unroll
    for (int kk = 0; kk < 8; ++kk) { const int c0 = kk * 16 + hi * 8;
        f32x4 acc0 = *(const LAS f32x4*)(CWl + 512 + c0), acc1 = *(const LAS f32x4*)(CWl + 512 + c0 + 4);
#pragma unroll
        for (int j = 0; j < 4; ++j) { const int tt = t + j - 2; const bool ok = tt >= 0 && tt < M; const int tc = ok ? tt : t;
            u32x4 xv = *(const u32x4*)(proj + (size_t)tc * NIN + C_XR + blk * 128 + c0);
            if (!ok) xv = (u32x4){0u, 0u, 0u, 0u};
            const f32x4 w0 = *(const LAS f32x4*)(CWl + j * 128 + c0), w1 = *(const LAS f32x4*)(CWl + j * 128 + c0 + 4);
            acc0.x += w0.x * bflo(xv.x); acc0.y += w0.y * bfhi(xv.x); acc0.z += w0.z * bflo(xv.y); acc0.w += w0.w * bfhi(xv.y);
            acc1.x += w1.x * bflo(xv.z); acc1.y += w1.y * bfhi(xv.z); acc1.z += w1.z * bflo(xv.w); acc1.w += w1.w * bfhi(xv.w); }
        u32x4 o; o.x = pk2(acc0.x, acc0.y); o.y = pk2(acc0.z, acc0.w); o.z = pk2(acc1.x, acc1.y); o.w = pk2(acc1.z, acc1.w);
        A[kk] = __builtin_bit_cast(bf16x8, o); if ((kk & 3) == 3) asm volatile("" ::: "memory"); }
    bf16x8 Bid[2];
#pragma unroll
    for (int kq = 0; kq < 2; ++kq)
#pragma unroll
        for (int j = 0; j < 8; ++j) Bid[kq][j] = (16 * kq + 8 * hi + j == r32) ? (short)0x3F80 : (short)0;
    unsigned* hcout = (unsigned*)(ws + (d ? WS_HB : WS_HF));
#pragma unroll
    for (int rd = 0; rd < 4; ++rd) {
        float hl[1][16], cq[1][16];
#pragma unroll
        for (int cc = 0; cc < 1; ++cc) { const int ct = rd + cc;
            f32x16 accr = {}, acci = {}, accx = {};
#pragma unroll
            for (int kk = 0; kk < 8; ++kk) {
                const bf16x8 br = *(const LAS bf16x8*)(lds + L_WT + KSWZ_(ct * 32 + r32, (kk * 16 + hi * 8) * 2));
                const bf16x8 bi = *(const LAS bf16x8*)(lds + L_WT + KSWZ_(128 + ct * 32 + r32, (kk * 16 + hi * 8) * 2));
                accr = __builtin_amdgcn_mfma_f32_32x32x16_bf16(A[kk], br, accr, 0, 0, 0);
                acci = __builtin_amdgcn_mfma_f32_32x32x16_bf16(A[kk], bi, acci, 0, 0, 0);
            }
            accx = __builtin_amdgcn_mfma_f32_32x32x16_bf16(A[2 * ct], Bid[0], accx, 0, 0, 0);
            accx = __builtin_amdgcn_mfma_f32_32x32x16_bf16(A[2 * ct + 1], Bid[1], accx, 0, 0, 0);
            const int cidx = d * 1024 + blk * 128 + ct * 32 + r32;
            const float ba = a.in[I_BA][cidx], bx = a.in[I_BX][cidx], lam = a.in[I_LAM][cidx];
            const float sp8 = 8.f * log1pf(__expf(-lam));
            float av[16], bv[16];
#pragma unroll
            for (int r = 0; r < 16; ++r) {
                const float rg = __builtin_amdgcn_rcpf(1.f + __builtin_amdgcn_exp2f(-1.4426950408889634f * (accr[r] + ba)));
                const float ig = __builtin_amdgcn_rcpf(1.f + __builtin_amdgcn_exp2f(-1.4426950408889634f * (acci[r] + bx)));
                const float la = -sp8 * rg; const float aa = __builtin_amdgcn_exp2f(1.4426950408889634f * la);
                const float om = __builtin_fmaf(-aa, aa, 1.f);
                av[r] = aa; bv[r] = __builtin_amdgcn_sqrtf(om) * ig * accx[r];
            }
            float Pg[4], Hg[4];
#pragma unroll
            for (int g = 0; g < 4; ++g) { float h = 0.f, cp = 1.f;
#pragma unroll
                for (int e = 0; e < 4; ++e) { const int r = 4 * g + (DIR == 0 ? e : 3 - e); h = av[r] * h + bv[r]; cp *= av[r]; bv[r] = h; av[r] = cp; }
                Pg[g] = cp; Hg[g] = h; }
            float F = 1.f, E = 0.f, Fg[4], Eg[4];
#pragma unroll
            for (int gi = 0; gi < 4; ++gi) { const int g = DIR == 0 ? gi : 3 - gi;
                const float pP = __shfl_xor(Pg[g], 32), pH = __shfl_xor(Hg[g], 32);
                const float Pe = hi ? pP : Pg[g], He = hi ? pH : Hg[g];
                const float Po = hi ? Pg[g] : pP, Ho = hi ? Hg[g] : pH;
                if (DIR == 0) { const float F1 = Pe * F, E1 = Pe * E + He; Fg[g] = hi ? F1 : F; Eg[g] = hi ? E1 : E; F = Po * F1; E = Po * E1 + Ho; }
                else          { const float F1 = Po * F, E1 = Po * E + Ho; Fg[g] = hi ? F : F1; Eg[g] = hi ? E : E1; F = Pe * F1; E = Pe * E1 + He; } }
            if (hi == 0) { f32x2 o; o.x = F; o.y = E; SUM[(rd * 8 + w) * 32 + r32] = o; }
#pragma unroll
            for (int r = 0; r < 16; ++r) { hl[cc][r] = bv[r] + av[r] * Eg[r >> 2]; cq[cc][r] = av[r] * Fg[r >> 2]; }
        }
        __syncthreads();
        {
            const int ct = rd; float Fw = 1.f, Ew = 0.f;
            if (DIR == 0) { for (int wp = 0; wp < w; ++wp) { const f32x2 fe = SUM[(rd * 8 + wp) * 32 + r32]; Ew = fe.x * Ew + fe.y; Fw *= fe.x; } }
            else          { for (int wp = 7; wp > w; --wp) { const f32x2 fe = SUM[(rd * 8 + wp) * 32 + r32]; Ew = fe.x * Ew + fe.y; Fw *= fe.x; } }
            const size_t o0 = (size_t)(ck * 256 + w * 32) * LW + blk * 128 + ct * 32 + r32;
#pragma unroll
            for (int r = 0; r < 16; ++r) { const size_t oo = o0 + (size_t)crow_(r, hi) * LW;
                hcout[oo] = pk2(hl[0][r] + cq[0][r] * Ew, cq[0][r] * Fw); }
        }
        if (tid < 32) {
            float F = 1.f, E = 0.f;
#pragma unroll
            for (int wi = 0; wi < 8; ++wi) { const int wp = DIR == 0 ? wi : 7 - wi; const f32x2 fe = SUM[(rd * 8 + wp) * 32 + tid]; E = fe.x * E + fe.y; F *= fe.x; }
            f32x2 o; o.x = F; o.y = E; ((f32x2*)(ws + WS_SUMM))[(ck * 2 + d) * 1024 + blk * 128 + rd * 32 + tid] = o;
        }
    }
}
__device__ __forceinline__ void lru_phase(const Args& a, LAS unsigned char* lds, int bid, int G, int nrep) {
    const int key = bid & 15, d = key & 1, blk = key >> 1, ck0 = bid >> 4, dck = G >> 4;
    if (d == 0) { bool first = true; for (int c_ = ck0; c_ < 64 * nrep; c_ += dck) { lru_unit<0>(a, lds, c_ & 63, blk, first); first = false; } }
    else        { bool first = true; for (int c_ = ck0; c_ < 64 * nrep; c_ += dck) { lru_unit<1>(a, lds, c_ & 63, blk, first); first = false; } }
    __syncthreads();
}
__device__ __forceinline__ void carry_phase(const Args& a, int gw, int NGW, int lane) {
    const f32x2* summ = (const f32x2*)(a.ws + WS_SUMM); float* carry = (float*)(a.ws + WS_CARRY);
    for (int ch = gw; ch < 2048; ch += NGW) { const int d = ch >> 10, c = ch & 1023, kk = d ? 63 - lane : lane;
        const f32x2 s = summ[(kk * 2 + d) * 1024 + c]; float P = s.x, H = s.y;
#pragma unroll
        for (int off = 1; off < 64; off <<= 1) { const float Pp = __shfl_up(P, off), Hp = __shfl_up(H, off); if (lane >= off) { H = P * Hp + H; P = P * Pp; } }
        const float cin = __shfl_up(H, 1);
        carry[(kk * 2 + d) * 1024 + c] = lane ? cin : 0.f; }
}

__device__ __forceinline__ void p4_mix(const Args& a, int gw, int NGW, int lane) {
    unsigned char* ws = a.ws;
    const bf16r* proj = (const bf16r*)(ws + WS_PROJ); bf16r* mixed = (bf16r*)(ws + WS_XN);
    const float* O = (const float*)(ws + WS_O);
    const unsigned* HCF = (const unsigned*)(ws + WS_HF); const unsigned* HCB = (const unsigned*)(ws + WS_HB);
    const float* carry = (const float*)(ws + WS_CARRY);
    const f32x4* anw = (const f32x4*)a.in[I_ANW] + lane; const f32x4* lnw = (const f32x4*)a.in[I_LNW] + lane;
    for (int b8 = gw; b8 < M / 8; b8 += NGW) {
        const int ck = b8 >> 5; f32x4 cf[4], cb[4];
#pragma unroll
        for (int j = 0; j < 4; ++j) { cf[j] = ((const f32x4*)(carry + (ck * 2 + 0) * 1024) + lane)[64 * j]; cb[j] = ((const f32x4*)(carry + (ck * 2 + 1) * 1024) + lane)[64 * j]; }
        for (int rr = 0; rr < 8; ++rr) { const int m = b8 * 8 + rr;
        f32x4 v[4], u[4]; float s1 = 0.f, s2 = 0.f;
#pragma unroll
        for (int j = 0; j < 4; ++j) {
            v[j] = ((const f32x4*)(O + (size_t)m * AW) + lane)[64 * j];
            const u32x4 f = ((const u32x4*)(HCF + (size_t)m * LW) + lane)[64 * j], b = ((const u32x4*)(HCB + (size_t)m * LW) + lane)[64 * j];
            u[j].x = (bflo(f.x) + bfhi(f.x) * cf[j].x) + (bflo(b.x) + bfhi(b.x) * cb[j].x);
            u[j].y = (bflo(f.y) + bfhi(f.y) * cf[j].y) + (bflo(b.y) + bfhi(b.y) * cb[j].y);
            u[j].z = (bflo(f.z) + bfhi(f.z) * cf[j].z) + (bflo(b.z) + bfhi(b.z) * cb[j].z);
            u[j].w = (bflo(f.w) + bfhi(f.w) * cf[j].w) + (bflo(b.w) + bfhi(b.w) * cb[j].w);
            s1 += (v[j].x * v[j].x + v[j].y * v[j].y) + (v[j].z * v[j].z + v[j].w * v[j].w);
            s2 += (u[j].x * u[j].x + u[j].y * u[j].y) + (u[j].z * u[j].z + u[j].w * u[j].w); }
        const float r1 = rsqrtf(wave_sum(s1) * (1.f / AW) + EPS), r2 = rsqrtf(wave_sum(s2) * (1.f / LW) + EPS);
        const u32x2* ga = (const u32x2*)(proj + (size_t)m * NIN + C_GA) + lane; const u32x2* gl = (const u32x2*)(proj + (size_t)m * NIN + C_GL) + lane;
        u32x2* mo = (u32x2*)(mixed + (size_t)m * MIXW) + lane;
#pragma unroll
        for (int j = 0; j < 4; ++j) {
            { const u32x2 g = ga[64 * j]; const f32x4 w = anw[64 * j];
              const float g0 = bflo(g.x), g1 = bfhi(g.x), g2 = bflo(g.y), g3 = bfhi(g.y);
              u32x2 o; o.x = pk2(v[j].x * r1 * w.x * g0 * sigmoidf_(g0), v[j].y * r1 * w.y * g1 * sigmoidf_(g1));
              o.y = pk2(v[j].z * r1 * w.z * g2 * sigmoidf_(g2), v[j].w * r1 * w.w * g3 * sigmoidf_(g3)); mo[64 * j] = o; }
            { const u32x2 g = gl[64 * j]; const f32x4 w = lnw[64 * j];
              const float g0 = bflo(g.x), g1 = bfhi(g.x), g2 = bflo(g.y), g3 = bfhi(g.y);
              u32x2 o; o.x = pk2(u[j].x * r2 * w.x * g0 * sigmoidf_(g0), u[j].y * r2 * w.y * g1 * sigmoidf_(g1));
              o.y = pk2(u[j].z * r2 * w.z * g2 * sigmoidf_(g2), u[j].w * r2 * w.w * g3 * sigmoidf_(g3)); mo[256 + 64 * j] = o; }
        }
        }
    }
}

#define RLX_AGENT __ATOMIC_RELAXED, __HIP_MEMORY_SCOPE_AGENT
#define XB_TMO      128
#define XB_XCNT(j)  (256  + 64 * (j))
#define XB_XSUB(j)  (1280 + 64 * (j))
#define XB_XGEN(j)  (2304 + 64 * (j))
#define XB_TOP      3328
#define XB_TOPGEN   3392
#define XCD_BAR_WORDS 3456
#define XB_SPIN_CAP (1u << 18)

__device__ __forceinline__ unsigned xb_ld(unsigned* p)              { return __hip_atomic_load(p, __ATOMIC_RELAXED, __HIP_MEMORY_SCOPE_AGENT); }
__device__ __forceinline__ unsigned xb_add(unsigned* p, unsigned v) { return __hip_atomic_fetch_add(p, v, __ATOMIC_RELAXED, __HIP_MEMORY_SCOPE_AGENT); }
__device__ __forceinline__ unsigned xb_xcc_id() { return (unsigned)__builtin_amdgcn_s_getreg((3 << 11) | 20) & 0xFu; }
#define XB_SPIN(cond, bar) do { unsigned _sp = 0; while (cond) { __builtin_amdgcn_s_sleep(1); \
    if ((++_sp & 255u) == 0u) { if (xb_ld(&(bar)[XB_TMO])) break; if (_sp > XB_SPIN_CAP) { atomicAdd(&(bar)[XB_TMO], 1u); break; } } } } while (0)

struct XcdBarrier {
    unsigned* bar; unsigned x;
    volatile LAS unsigned* st;
};

__device__ __forceinline__ XcdBarrier xcd_barrier_post(unsigned* bar, volatile LAS unsigned* st) {
    XcdBarrier b; b.bar = bar; b.x = xb_xcc_id(); b.st = st;
    if (threadIdx.x == 0) (void)xb_add(&bar[XB_XCNT(b.x)], 1u);
    return b;
}
__device__ __forceinline__ void xcd_barrier_complete(unsigned* bar, unsigned x, unsigned& nloc, unsigned& nx) {
    const unsigned G = gridDim.x * gridDim.y * gridDim.z;
    unsigned sum, cnt, mine, sp = 0u;
    for (;;) {
        sum = 0u; cnt = 0u; mine = 0u;
#pragma unroll
        for (unsigned j = 0; j < 16; ++j) { const unsigned c = xb_ld(&bar[XB_XCNT(j)]); sum += c; cnt += (c > 0u) ? 1u : 0u; mine = (j == x) ? c : mine; }
        if (sum == G) break;
        __builtin_amdgcn_s_sleep(1);
        if ((++sp & 255u) == 0u) { if (xb_ld(&bar[XB_TMO])) break; if (sp > XB_SPIN_CAP) { atomicAdd(&bar[XB_TMO], 1u); break; } }
    }
    nloc = mine > 0u ? mine : 1u; nx = cnt > 0u ? cnt : 1u;
}

__device__ __forceinline__ void xcd_barrier(const XcdBarrier& b) {
    asm volatile("s_waitcnt vmcnt(0)" ::: "memory");
    __syncthreads();
    if (threadIdx.x == 0) {
        unsigned* bar = b.bar;
        __builtin_amdgcn_s_waitcnt(0);
        unsigned nloc = b.st[0], nx = b.st[1];
        if (nloc == 0u) { xcd_barrier_complete(bar, b.x, nloc, nx); b.st[0] = nloc; b.st[1] = nx; }
        const unsigned old = xb_add(&bar[XB_XSUB(b.x)], 1u);
        const unsigned gen = old / nloc;
        if (old + 1u == (gen + 1u) * nloc) {
            __builtin_amdgcn_fence(__ATOMIC_RELEASE, "agent");
            asm volatile("s_waitcnt vmcnt(0)" ::: "memory");
            const unsigned og = xb_add(&bar[XB_TOP], 1u);
            const unsigned tg = og / nx;
            if (og + 1u == (tg + 1u) * nx) xb_add(&bar[XB_TOPGEN], 1u);
            else XB_SPIN(xb_ld(&bar[XB_TOPGEN]) == tg, bar);
            __builtin_amdgcn_fence(__ATOMIC_ACQUIRE, "agent");
            xb_add(&bar[XB_XGEN(b.x)], 1u);
            asm volatile("s_waitcnt vmcnt(0)" ::: "memory");
        } else {
            XB_SPIN(xb_ld(&bar[XB_XGEN(b.x)]) == gen, bar);
            __builtin_amdgcn_fence(__ATOMIC_ACQUIRE, "agent");
            asm volatile("s_waitcnt vmcnt(0)" ::: "memory");
        }
    }
    __syncthreads();
}

__global__ void __launch_bounds__(NTHREADS) hybrid_fwd(Args args) {
    extern __shared__ __attribute__((aligned(16))) unsigned char lds_raw[];
    LAS unsigned char* lds = (LAS unsigned char*)lds_raw;
    __shared__ __attribute__((aligned(16))) unsigned xb_st[4];
    cg::grid_group grid = cg::this_grid();
    const int tid = threadIdx.x, lane = tid & 63, wave = __builtin_amdgcn_readfirstlane(tid >> 6);
    if (tid < 4) xb_st[tid] = 0u;
    __syncthreads();
    const XcdBarrier xbar = xcd_barrier_post((unsigned*)args.ws, (volatile LAS unsigned*)xb_st);
    const int G = gridDim.x, bid = blockIdx.x;
    const int gw = bid * NWAVES + wave, NGW = G * NWAVES;
    unsigned char* ws = args.ws;
    const int lo = args.ph_lo, hi = args.ph_hi;
#define IN(k) (lo <= (k) && (k) < hi)
#ifndef REP
#define REP -1
#endif
#define NREP(k) ((REP) == (k) ? 2 : 1)
#define SEAM(k) do { if (IN(k) && IN((k) + 1)) xcd_barrier(xbar); } while (0)
    if (lo > hi) grid.sync();

    if (IN(0)) { p0_prologue(args, lds, gw, NGW, lane, wave); __syncthreads(); }
    SEAM(0);
    if (IN(1)) {
        pg8::Gemm g{(const pg8::bf16_t*)(ws + WS_XN), (const pg8::bf16_t*)(ws + WS_WIN), M, NIN, DM}; pg8::StaticOrder S; S.init(M, NIN, G, bid);
        pg8::EpiStoreBf16 E{(pg8::bf16_t*)(ws + WS_PROJ), NIN};
        pg8::gemm_phase<pg8::EpiStoreBf16, pg8::StaticOrder, true, true>(lds, g, S, E);
        __syncthreads();
    }
    SEAM(1);
    if (IN(2)) p2_qkprep(args, gw, NGW, lane);
    SEAM(2);
    if (IN(3)) {
        const att::bf16* proj = (const att::bf16*)(ws + WS_PROJ);
        for (int u = bid; u < 512; u += G) { const int h = u >> 6, qb = u & 63, kvh = h >> 2;
            att::attn_dense_body<att::bf16>(proj + (size_t)qb * 256 * NIN + C_Q + h * 128, proj + C_K + kvh * 128, proj + C_V + kvh * 128,
                                            (float*)(ws + WS_O) + (size_t)qb * 256 * AW + h * 128, M, (char*)lds_raw, args.in[I_QNW], args.in[I_KNW], (const float*)(ws + WS_TAB), qb * 256);
            __syncthreads(); }
        lru_phase(args, lds, bid, G, 1);
    }
    SEAM(3);
    if (IN(4)) carry_phase(args, gw, NGW, lane);
    SEAM(4);
    if (IN(5)) p4_mix(args, gw, NGW, lane);
    SEAM(5);
    if (IN(6)) {
        pg8::Gemm g{(const pg8::bf16_t*)(ws + WS_XN), (const pg8::bf16_t*)(ws + WS_WOUT), M, DM, MIXW}; pg8::StaticOrder S; S.init(M, DM, G, bid);
        pg8::EpiResidual E{args.in[I_X], args.out, DM};
        pg8::gemm_phase<pg8::EpiResidual, pg8::StaticOrder, true, true>(lds, g, S, E);
    }
#undef IN
#undef SEAM
}

#ifndef N_LAUNCHES
#define N_LAUNCHES 1
#endif
extern "C" void kernel_launch(void* const* d_in, const int* in_sizes, int n_in, void* d_out, int out_size, void* d_ws, size_t ws_size, hipStream_t stream) {
    static int grid = 0;
    if (grid == 0) {
        if (n_in != 15 || in_sizes[0] != M * DM || out_size != M * DM || ws_size < WS_END) { fprintf(stderr, "kernel_launch: shape/workspace mismatch (n_in %d, ws %zu)\n", n_in, ws_size); grid = -1; return; }
        int dev = 0, cus = 0, per_cu = 0;
        (void)hipGetDevice(&dev); (void)hipDeviceGetAttribute(&cus, hipDeviceAttributeMultiprocessorCount, dev);
        if (hipFuncSetAttribute((const void*)hybrid_fwd, hipFuncAttributeMaxDynamicSharedMemorySize, LDS_BYTES) != hipSuccess) { fprintf(stderr, "kernel_launch: hipFuncSetAttribute failed\n"); grid = -1; return; }
        if (hipOccupancyMaxActiveBlocksPerMultiprocessor(&per_cu, (const void*)hybrid_fwd, NTHREADS, LDS_BYTES) != hipSuccess || per_cu < 1) { fprintf(stderr, "kernel_launch: occupancy query gave %d\n", per_cu); per_cu = 1; }
        (void)hipGetLastError();
        grid = cus * 1;
    }
    if (grid < 0) return;
    Args a{};
    for (int i = 0; i < 15; ++i) a.in[i] = (const float*)d_in[i];
    a.out = (float*)d_out; a.ws = (unsigned char*)d_ws;
    if (hipMemsetAsync(d_ws, 0, 16384, stream) != hipSuccess) { fprintf(stderr, "kernel_launch: hipMemsetAsync failed\n"); return; }
    if (N_LAUNCHES == 1) {
        a.ph_lo = 0; a.ph_hi = 7;
        void* kargs[] = {&a};
        hipError_t e = hipLaunchCooperativeKernel((const void*)hybrid_fwd, dim3(grid), dim3(NTHREADS), kargs, LDS_BYTES, stream);
        if (e != hipSuccess) fprintf(stderr, "cooperative launch failed: %s (grid %d)\n", hipGetErrorString(e), grid);
    } else {
        for (int p = 0; p < 7; ++p) { a.ph_lo = p; a.ph_hi = p + 1; hipLaunchKernelGGL(hybrid_fwd, dim3(grid), dim3(NTHREADS), LDS_BYTES, stream, a); }
    }
}
```

```cpp
#include <hip/hip_runtime.h>
#include <hip/hip_bf16.h>
#include <hip/hip_cooperative_groups.h>
#include <cstdio>
#include <cstdint>
namespace cg = cooperative_groups;
namespace pg8 {
#define PG8_LAS __attribute__((address_space(3)))
typedef unsigned short bf16_t;
typedef short bf16x8 __attribute__((ext_vector_type(8)));
typedef float f32x4 __attribute__((ext_vector_type(4)));
typedef unsigned u32x4 __attribute__((ext_vector_type(4)));
constexpr int BM = 256, BK = 64, HALF = 128, HTB = HALF * BK * 2  , STAGE_BYTES = 8 * HTB, NXCD = 8, WGM = 8;

__host__ __device__ __forceinline__ int lds_byte(int r, int c) { const int st = (r >> 4) * 2 + (c >> 5), rr = r & 15, cc = c & 31, ob = rr * 64 + cc * 2; return st * 1024 + (ob ^ (((ob >> 9) & 1) << 5)); }
__host__ __device__ __forceinline__ void stage_rc(int b, int& R, int& C) { const int st = b / 1024, sb = b % 1024, swz = sb ^ (((sb >> 9) & 1) << 5); R = (st >> 1) * 16 + swz / 64; C = (st & 1) * 32 + (swz % 64) / 2; }
__host__ __device__ __forceinline__ int perm32(int rho) { const int n = rho >> 4, i = rho & 15; return 8 * (i >> 2) + 4 * n + (i & 3); }

struct Unit { int pm, pn; };
struct Gemm { const bf16_t* A; const bf16_t* Bt; int M, N, K; };

struct StaticOrder {
    int nM, nN, nwg, G, c;
    __host__ __device__ void init(int M, int N, int G_, int c_) { nM = M / BM; nN = N / BM; nwg = nM * nN; G = G_; c = c_; }
    __host__ __device__ bool next(int i, Unit& u) const {
        const long L = (long)i * G + c; if (L >= nwg) return false;
        int wgid = (int)L; { const int q = nwg / NXCD, r = nwg % NXCD, xcd = wgid % NXCD, off = wgid / NXCD; wgid = (xcd < r ? xcd * (q + 1) : r * (q + 1) + (xcd - r) * q) + off; }
        const int nig = WGM * nN, gid = wgid / nig, fm = gid * WGM, gsz = (nM - fm) < WGM ? (nM - fm) : WGM;
        u.pm = fm + ((wgid % nig) % gsz); u.pn = (wgid % nig) / gsz; return true;
    }
    __device__ __forceinline__ void a_ready(const Unit&) const {}
    __device__ __forceinline__ void done(const Unit&) const {}
};

__device__ __forceinline__ unsigned cvt_pk_bf16(float lo, float hi) { unsigned r; asm volatile("v_cvt_pk_bf16_f32 %0, %1, %2" : "=v"(r) : "v"(lo), "v"(hi)); return r; }
__device__ __forceinline__ void store16_wt(void* p, u32x4 v) { asm volatile("global_store_dwordx4 %0, %1, off sc1" :: "v"(p), "v"(v) : "memory"); }
struct EpiStoreBf16 {
    static constexpr bool PERM = true, AFTER_DRAIN = false;
    bf16_t* O; int ldc;
    __device__ __forceinline__ void operator()(const f32x4 (&acc)[2][2][4][2], const Unit& u, int wr, int wc, int fr, int fq) const {
        const int row0 = u.pm * BM + wr * 64 + fr; const int col0 = u.pn * BM + wc * 32 + 8 * fq;
#pragma unroll
        for (int ai = 0; ai < 2; ++ai)
#pragma unroll
            for (int m = 0; m < 4; ++m) { bf16_t* rowp = O + (size_t)(row0 + ai * HALF + m * 16) * ldc + col0;
#pragma unroll
                for (int bj = 0; bj < 2; ++bj) { const f32x4 v0 = acc[ai][bj][m][0], v1 = acc[ai][bj][m][1];
                    u32x4 w; w.x = cvt_pk_bf16(v0[0], v0[1]); w.y = cvt_pk_bf16(v0[2], v0[3]); w.z = cvt_pk_bf16(v1[0], v1[1]); w.w = cvt_pk_bf16(v1[2], v1[3]);
                    store16_wt(rowp + bj * HALF, w); } }
    }
};
struct EpiResidual {
    static constexpr bool PERM = false, AFTER_DRAIN = false;
    const float* x; float* out; int ldc;
    __device__ __forceinline__ void operator()(const f32x4 (&acc)[2][2][4][2], const Unit& u, int wr, int wc, int fr, int fq) const {
        const int row0 = u.pm * BM + wr * 64 + fr; const int col0 = u.pn * BM + wc * 32 + 4 * fq;
#pragma unroll
        for (int ai = 0; ai < 2; ++ai)
#pragma unroll
            for (int m = 0; m < 4; ++m) { const size_t off = (size_t)(row0 + ai * HALF + m * 16) * ldc + col0;
#pragma unroll
                for (int bj = 0; bj < 2; ++bj)
#pragma unroll
                    for (int n = 0; n < 2; ++n) { const f32x4 xv = *(const f32x4*)(x + off + bj * HALF + n * 16); *(f32x4*)(out + off + bj * HALF + n * 16) = xv + acc[ai][bj][m][n]; } }
    }
};
template <class Epi, class Sched, bool ALIGN_EPI = false, bool SP2 = false>
__device__ __forceinline__ void gemm_phase(PG8_LAS unsigned char* lds, const Gemm g, const Sched& S, const Epi& E) {
    const int tid = threadIdx.x, wid = __builtin_amdgcn_readfirstlane(tid >> 6), lane = tid & 63, wr = wid >> 2, wc = wid & 3, fr = lane & 15, fq = lane >> 4;
    const int K = g.K, nt = K / BK;
    unsigned voffA[2], voffB[2];
#pragma unroll
    for (int i = 0; i < 2; ++i) { int R, C; stage_rc(tid * 16 + i * 8192, R, C); const int Rb = Epi::PERM ? ((R & ~31) + perm32(R & 31)) : R;
        voffA[i] = (unsigned)(R * K + C) * 2u; voffB[i] = (unsigned)(Rb * K + C) * 2u; }
    const size_t kstep = (size_t)(BK * 2);
    const size_t hstep = (size_t)HALF * K * 2;
    const size_t tstep = 2 * hstep;
    const unsigned ldsw = (unsigned)wid * 1024u;
    const int aoff = lds_byte(wr * 64 + fr, fq * 8), boff = lds_byte(wc * 32 + fr, fq * 8);
#define PG8_SA(b, h) (((b) * 2 + (h)) * HTB)
#define PG8_SB(b, h) ((4 + (b) * 2 + (h)) * HTB)
#define PG8_STAGE(bufoff, gbase, voff) do { _Pragma("unroll") for (int _i = 0; _i < 2; ++_i) \
        __builtin_amdgcn_global_load_lds((const unsigned*)((const char*)(gbase) + (voff)[_i]), (PG8_LAS unsigned*)(lds + (bufoff) + ldsw + _i * 8192), 16, 0, 0); } while (0)
#define PG8_LDA(dst, b, h) do { _Pragma("unroll") for (int m = 0; m < 4; ++m) _Pragma("unroll") for (int k = 0; k < 2; ++k) dst[m][k] = *(const PG8_LAS bf16x8*)(lds + PG8_SA(b, h) + aoff + m * 2048 + k * 1024); } while (0)
#define PG8_LDB(dst, b, h) do { _Pragma("unroll") for (int n = 0; n < 2; ++n) _Pragma("unroll") for (int k = 0; k < 2; ++k) dst[n][k] = *(const PG8_LAS bf16x8*)(lds + PG8_SB(b, h) + boff + n * 2048 + k * 1024); } while (0)
#define PG8_MMA(ai, bj, At, Bt) do { __builtin_amdgcn_s_setprio(1); _Pragma("unroll") for (int m = 0; m < 4; ++m) _Pragma("unroll") for (int n = 0; n < 2; ++n) _Pragma("unroll") for (int k = 0; k < 2; ++k) \
        acc[ai][bj][m][n] = __builtin_amdgcn_mfma_f32_16x16x32_bf16(Bt[n][k], At[m][k], acc[ai][bj][m][n], 0, 0, 0); __builtin_amdgcn_s_setprio(0); } while (0)
#define PG8_WAIT_V(n) asm volatile("s_waitcnt vmcnt(" #n ")" ::: "memory")
#define PG8_WAIT_L(n) asm volatile("s_waitcnt lgkmcnt(" #n ")" ::: "memory")
#define PG8_BAR __builtin_amdgcn_s_barrier()
#define PG8_SCHED __builtin_amdgcn_sched_barrier(0)
    Unit cur, nxt; int ui = 0;
    if (!S.next(0, cur)) return;
    f32x4 acc[2][2][4][2];
#pragma unroll
    for (int a = 0; a < 2; ++a)
#pragma unroll
        for (int b = 0; b < 2; ++b)
#pragma unroll
            for (int m = 0; m < 4; ++m)
#pragma unroll
                for (int n = 0; n < 2; ++n) acc[a][b][m][n] = (f32x4){0.f, 0.f, 0.f, 0.f};
    bf16x8 At[4][2], B0[2][2], B1[2][2];
    const char* cA = (const char*)g.A + (size_t)cur.pm * tstep; const char* cB = (const char*)g.Bt + (size_t)cur.pn * tstep;
    S.a_ready(cur);
    if constexpr (SP2) {
        PG8_STAGE(PG8_SB(0, 0), cB, voffB); PG8_STAGE(PG8_SB(0, 1), cB + hstep, voffB); PG8_STAGE(PG8_SA(0, 0), cA, voffA); PG8_STAGE(PG8_SA(0, 1), cA + hstep, voffA);
        if (wr == 1) PG8_BAR;
        PG8_WAIT_V(2); PG8_BAR;
        PG8_STAGE(PG8_SB(1, 0), cB + kstep, voffB); PG8_STAGE(PG8_SA(1, 0), cA + kstep, voffA); PG8_STAGE(PG8_SB(1, 1), cB + hstep + kstep, voffB);
        PG8_WAIT_V(6); PG8_BAR;
    } else {
        PG8_STAGE(PG8_SB(0, 0), cB, voffB); PG8_STAGE(PG8_SA(0, 0), cA, voffA); PG8_STAGE(PG8_SB(0, 1), cB + hstep, voffB); PG8_STAGE(PG8_SA(0, 1), cA + hstep, voffA);
        if (wr == 1) PG8_BAR;
        PG8_WAIT_V(4); PG8_BAR;
        PG8_STAGE(PG8_SB(1, 0), cB + kstep, voffB); PG8_STAGE(PG8_SA(1, 0), cA + kstep, voffA); PG8_STAGE(PG8_SB(1, 1), cB + hstep + kstep, voffB);
        PG8_WAIT_V(6); PG8_BAR;
    }
    for (;;) {
        const bool has_next = S.next(ui + 1, nxt);
        const char* nA = has_next ? (const char*)g.A + (size_t)nxt.pm * tstep : cA; const char* nB = has_next ? (const char*)g.Bt + (size_t)nxt.pn * tstep : cB;
        for (int t = 0; t < nt; t += 2) {
            const bool last = (t == nt - 2);
            const char* a1 = cA + (size_t)(t + 1) * kstep;
            const char* a2 = last ? nA : cA + (size_t)(t + 2) * kstep; const char* b2 = last ? nB : cB + (size_t)(t + 2) * kstep;
            const char* a3 = a2 + kstep; const char* b3 = b2 + kstep;
            if (last && has_next) S.a_ready(nxt);
            if constexpr (SP2) {
            PG8_LDB(B0, 0, 0); PG8_LDB(B1, 0, 1); PG8_SCHED; PG8_LDA(At, 0, 0); PG8_STAGE(PG8_SA(1, 1), a1 + hstep, voffA);
            PG8_WAIT_V(8); PG8_WAIT_L(0); PG8_BAR; PG8_MMA(0, 0, At, B0); PG8_MMA(0, 1, At, B1); PG8_BAR; PG8_SCHED;
            PG8_LDA(At, 0, 1); PG8_STAGE(PG8_SB(0, 0), b2, voffB); PG8_STAGE(PG8_SB(0, 1), b2 + hstep, voffB); PG8_STAGE(PG8_SA(0, 0), a2, voffA);
            PG8_WAIT_V(8); PG8_WAIT_L(0); PG8_BAR; PG8_MMA(1, 0, At, B0); PG8_MMA(1, 1, At, B1); PG8_BAR; PG8_SCHED;
            PG8_LDB(B0, 1, 0); PG8_LDB(B1, 1, 1); PG8_SCHED; PG8_LDA(At, 1, 0); PG8_STAGE(PG8_SA(0, 1), a2 + hstep, voffA);
            PG8_WAIT_V(8); PG8_WAIT_L(0); PG8_BAR; PG8_MMA(0, 0, At, B0); PG8_MMA(0, 1, At, B1); PG8_BAR; PG8_SCHED;
            PG8_LDA(At, 1, 1); PG8_STAGE(PG8_SB(1, 0), b3, voffB); PG8_STAGE(PG8_SB(1, 1), b3 + hstep, voffB); PG8_STAGE(PG8_SA(1, 0), a3, voffA);
            PG8_WAIT_V(8); PG8_WAIT_L(0); PG8_BAR; PG8_MMA(1, 0, At, B0); PG8_MMA(1, 1, At, B1); PG8_BAR; PG8_SCHED;
            } else {
            PG8_LDB(B0, 0, 0); PG8_SCHED; PG8_LDA(At, 0, 0); PG8_STAGE(PG8_SA(1, 1), a1 + hstep, voffA);
            PG8_WAIT_L(8); PG8_BAR; PG8_WAIT_L(0); PG8_MMA(0, 0, At, B0); PG8_BAR; PG8_SCHED;
            PG8_LDB(B1, 0, 1); PG8_STAGE(PG8_SB(0, 0), b2, voffB);
            PG8_BAR; PG8_WAIT_L(0); PG8_MMA(0, 1, At, B1); PG8_BAR;
            PG8_LDA(At, 0, 1); PG8_STAGE(PG8_SA(0, 0), a2, voffA);
            PG8_BAR; PG8_WAIT_L(0); PG8_MMA(1, 0, At, B0); PG8_BAR; PG8_SCHED;
            PG8_STAGE(PG8_SB(0, 1), b2 + hstep, voffB);
            PG8_WAIT_V(6); PG8_BAR; PG8_MMA(1, 1, At, B1); PG8_BAR;
            PG8_LDB(B0, 1, 0); PG8_SCHED; PG8_LDA(At, 1, 0); PG8_STAGE(PG8_SA(0, 1), a2 + hstep, voffA);
            PG8_WAIT_L(8); PG8_BAR; PG8_WAIT_L(0); PG8_MMA(0, 0, At, B0); PG8_BAR; PG8_SCHED;
            PG8_LDB(B1, 1, 1); PG8_STAGE(PG8_SB(1, 0), b3, voffB);
            PG8_BAR; PG8_WAIT_L(0); PG8_MMA(0, 1, At, B1); PG8_BAR;
            PG8_LDA(At, 1, 1); PG8_STAGE(PG8_SA(1, 0), a3, voffA);
            PG8_BAR; PG8_WAIT_L(0); PG8_MMA(1, 0, At, B0); PG8_BAR; PG8_SCHED;
            PG8_STAGE(PG8_SB(1, 1), b3 + hstep, voffB);
            PG8_WAIT_V(6); PG8_BAR; PG8_MMA(1, 1, At, B1); PG8_BAR;
            }
        }
        if constexpr (ALIGN_EPI) { if (wr == 0) PG8_BAR; }
        if constexpr (!Epi::AFTER_DRAIN) { E(acc, cur, wr, wc, fr, fq); S.done(cur); }
        if (!has_next) break;
#pragma unroll
        for (int a = 0; a < 2; ++a)
#pragma unroll
            for (int b = 0; b < 2; ++b)
#pragma unroll
                for (int m = 0; m < 4; ++m)
#pragma unroll
                    for (int n = 0; n < 2; ++n) acc[a][b][m][n] = (f32x4){0.f, 0.f, 0.f, 0.f};
        cur = nxt; cA = nA; cB = nB; ++ui;
        if constexpr (ALIGN_EPI) { if (wr == 1) PG8_BAR; }
    }
    PG8_WAIT_V(0);
    if constexpr (!ALIGN_EPI) { if (wr == 0) PG8_BAR; }
    PG8_BAR;
    if constexpr (Epi::AFTER_DRAIN) { E.fused(acc, cur, wr, wc, fr, fq, lds, wid, lane); S.done(cur); }
#undef PG8_SA
#undef PG8_SB
#undef PG8_STAGE
#undef PG8_LDA
#undef PG8_LDB
#undef PG8_MMA
#undef PG8_WAIT_V
#undef PG8_WAIT_L
#undef PG8_BAR
#undef PG8_SCHED
}
}
namespace att {
using bf16 = __hip_bfloat16;
constexpr int   D = 128, NW = 8, QBLK = 32, KVBLK = 64;
constexpr float SCALE = 0.088388347648318440f;
constexpr float THR2 = 11.f;
constexpr float QSCALE = SCALE * 1.4426950408889634f;
constexpr int SDEPTH = 1;
constexpr int LDQ = 4608, LDK = 4608, LDO = 1024;
constexpr size_t SHM_V = KVBLK * D * 2, SHM_K = KVBLK * D * 2, SHM_ATTN = 2 * SHM_V + 2 * SHM_K + NW * 64 * 4;
using bf16x8 = __attribute__((ext_vector_type(8))) short;
using s16x4  = __attribute__((ext_vector_type(4))) short;
using f32x16 = __attribute__((ext_vector_type(16))) float;
using f32x8  = __attribute__((ext_vector_type(8))) float;
using u32x4  = __attribute__((ext_vector_type(4))) unsigned;
#define KSWZ(row, colB) ((row) * 256 + ((colB) ^ (((row) & 7) << 4)))
#define SBAR() __builtin_amdgcn_sched_barrier(0)
__device__ __forceinline__ int crow(int r, int hi) { return (r & 3) + 8 * (r >> 2) + 4 * hi; }
__device__ __forceinline__ unsigned cvtpk(float lo, float hi) {
  unsigned r; asm volatile("v_cvt_pk_bf16_f32 %0, %1, %2" : "=v"(r) : "v"(lo), "v"(hi)); return r;
}
template <typename TIn> struct Stage;
template <> struct Stage<bf16>  { using T = bf16x8;
  __device__ static __forceinline__ T ld8(const bf16* p) { return *reinterpret_cast<const bf16x8*>(p); }
  __device__ static __forceinline__ bf16x8 tobf(T x) { return x; } };
template <> struct Stage<float> { using T = f32x8;
  __device__ static __forceinline__ T ld8(const float* p) { return *reinterpret_cast<const f32x8*>(p); }
  __device__ static __forceinline__ bf16x8 tobf(T x) {
    u32x4 w = {cvtpk(x[0], x[1]), cvtpk(x[2], x[3]), cvtpk(x[4], x[5]), cvtpk(x[6], x[7])}; return *reinterpret_cast<bf16x8*>(&w); } };

__device__ __forceinline__ void partialSM(f32x16& p0) {
#pragma unroll
  for (int r = 0; r < 16; ++r) p0[r] = __builtin_amdgcn_exp2f(p0[r]);
}
__device__ __forceinline__ void finishSM(f32x16& p0, f32x16& p1, float& l_reg, bf16x8& pa0, bf16x8& pa1, bf16x8& pa2, bf16x8& pa3) {
  for (int r = 0; r < 16; ++r) p1[r] = __builtin_amdgcn_exp2f(p1[r]);
  float ps = 0; for (int r = 0; r < 16; ++r) ps += p0[r]; for (int r = 0; r < 16; ++r) ps += p1[r];
  { auto rr = __builtin_amdgcn_permlane32_swap(__float_as_uint(ps), __float_as_uint(ps), false, false);
    ps = __uint_as_float(rr[0]) + __uint_as_float(rr[1]); }
  l_reg += ps;
#define PK4(P, BASE, OUT) do { unsigned a0 = cvtpk(P[BASE + 0], P[BASE + 1]), a1 = cvtpk(P[BASE + 2], P[BASE + 3]);   \
    unsigned b0 = cvtpk(P[BASE + 4], P[BASE + 5]), b1 = cvtpk(P[BASE + 6], P[BASE + 7]);                              \
    auto r0 = __builtin_amdgcn_permlane32_swap(a0, b0, false, false); auto r1 = __builtin_amdgcn_permlane32_swap(a1, b1, false, false); \
    u32x4 w = {r0[0], r1[0], r0[1], r1[1]}; OUT = *reinterpret_cast<bf16x8*>(&w); } while (0)
  PK4(p0, 0, pa0); PK4(p0, 8, pa1); PK4(p1, 0, pa2); PK4(p1, 8, pa3);
#undef PK4
}
__device__ __forceinline__ void qkt(f32x16& p0, f32x16& p1, const bf16* Ks, const bf16x8* qr, const f32x16& negm, int r32, int hi) {
  const char* kb = (const char*)Ks + r32 * 32 + hi * 16;
#pragma unroll
  for (int d0 = 0; d0 < 8; ++d0) {
    bf16x8 b0 = *reinterpret_cast<const bf16x8*>(kb + d0 * 2048);
    bf16x8 b1 = *reinterpret_cast<const bf16x8*>(kb + d0 * 2048 + 1024);
    if (d0 == 0) { p0 = __builtin_amdgcn_mfma_f32_32x32x16_bf16(b0, qr[0], negm, 0, 0, 0); p1 = __builtin_amdgcn_mfma_f32_32x32x16_bf16(b1, qr[0], negm, 0, 0, 0); }
    else { p0 = __builtin_amdgcn_mfma_f32_32x32x16_bf16(b0, qr[d0], p0, 0, 0, 0); p1 = __builtin_amdgcn_mfma_f32_32x32x16_bf16(b1, qr[d0], p1, 0, 0, 0); } }
}
__device__ __forceinline__ int v_st(int k, int c) { const int kk = (k & ~0xC) | ((k & 4) << 1) | ((k & 8) >> 1); return ((kk >> 3) * 4 + (c >> 5)) * 512 + ((kk & 7) * 32 + (c & 31)) * 2; }
__device__ __forceinline__ int v_rd_base(int lane) { return ((lane & 3) << 3) | (((lane >> 2) & 3) << 6) | (((lane >> 4) & 1) << 5) | (((lane >> 5) & 1) << 8); }
constexpr int v_rd_off(int d0, int ks, int half) { return d0 * 512 + ks * 4096 + half * 2048; }
template <int OFF> __device__ __forceinline__ s16x4 tr_read(int vb) {
  s16x4 r; asm volatile("ds_read_b64_tr_b16 %0, %1 offset:%2" : "=&v"(r) : "v"(vb), "i"(OFF) : "memory"); return r;
}
template <int D0> __device__ __forceinline__ void pv_one(f32x16& od, int vb, bf16x8 pa0, bf16x8 pa1, bf16x8 pa2, bf16x8 pa3) {
  const s16x4 l0 = tr_read<v_rd_off(D0, 0, 0)>(vb), h0 = tr_read<v_rd_off(D0, 0, 1)>(vb), l1 = tr_read<v_rd_off(D0, 1, 0)>(vb), h1 = tr_read<v_rd_off(D0, 1, 1)>(vb);
  const s16x4 l2 = tr_read<v_rd_off(D0, 2, 0)>(vb), h2 = tr_read<v_rd_off(D0, 2, 1)>(vb), l3 = tr_read<v_rd_off(D0, 3, 0)>(vb), h3 = tr_read<v_rd_off(D0, 3, 1)>(vb);
  asm volatile("s_waitcnt lgkmcnt(0)" ::: "memory"); SBAR();
#define PK(L, H) (bf16x8){L[0], L[1], L[2], L[3], H[0], H[1], H[2], H[3]}
  od = __builtin_amdgcn_mfma_f32_32x32x16_bf16(pa0, PK(l0, h0), od, 0, 0, 0);
  od = __builtin_amdgcn_mfma_f32_32x32x16_bf16(pa1, PK(l1, h1), od, 0, 0, 0);
  od = __builtin_amdgcn_mfma_f32_32x32x16_bf16(pa2, PK(l2, h2), od, 0, 0, 0);
  od = __builtin_amdgcn_mfma_f32_32x32x16_bf16(pa3, PK(l3, h3), od, 0, 0, 0);
#undef PK
}
__device__ __forceinline__ void pv_d0(f32x16* o, int vb, bf16x8 pa0, bf16x8 pa1, bf16x8 pa2, bf16x8 pa3) {
  pv_one<0>(o[0], vb, pa0, pa1, pa2, pa3); pv_one<1>(o[1], vb, pa0, pa1, pa2, pa3); pv_one<2>(o[2], vb, pa0, pa1, pa2, pa3); pv_one<3>(o[3], vb, pa0, pa1, pa2, pa3);
}

template <typename TQ>
__device__ __forceinline__ void attn_dense_body(const TQ* __restrict__ Qb, const bf16* __restrict__ Kh, const bf16* __restrict__ Vh,
                                                float* __restrict__ Ob, int seq, char* lds, const float* __restrict__ qnw, const float* __restrict__ knw, const float* __restrict__ tab, int t0) {
  using SQ = Stage<TQ>;
  typedef __attribute__((address_space(3))) unsigned lds_u32;
  const int tid = threadIdx.x, lane = tid & 63, r32 = lane & 31, hi = lane >> 5;
  const int wid = __builtin_amdgcn_readfirstlane(tid >> 6);
  char* K_lds = lds; char* V_lds = lds + 4 * SHM_K;
  float* ws = (float*)(lds + 4 * SHM_V + 4 * SHM_K) + wid * 64; float* li_l = ws; float* al_l = ws + 32;
  float l_reg = 0; f32x16 o[4] = {}; bf16x8 qr[8]; f32x16 negm = {}; asm volatile("" : "+v"(negm));
  const TQ* Qw = Qb + (long)(wid * QBLK + r32) * LDQ + hi * 8;
  {
    const int t = t0 + wid * QBLK + r32; float x[8][8]; float ss = 0.f;
#pragma unroll
    for (int d0 = 0; d0 < 8; ++d0) { const u32x4 raw = *reinterpret_cast<const u32x4*>(Qw + d0 * 16);
#pragma unroll
      for (int k = 0; k < 4; ++k) { x[d0][2 * k] = __uint_as_float(raw[k] << 16); x[d0][2 * k + 1] = __uint_as_float(raw[k] & 0xffff0000u); ss += x[d0][2 * k] * x[d0][2 * k] + x[d0][2 * k + 1] * x[d0][2 * k + 1]; } }
    { auto rr = __builtin_amdgcn_permlane32_swap(__float_as_uint(ss), __float_as_uint(ss), false, false); ss = __uint_as_float(rr[0]) + __uint_as_float(rr[1]); }
    const float rstd = rsqrtf(ss * (1.f / 128.f) + 1e-6f); float n2 = 0.f;
#pragma unroll
    for (int d0 = 0; d0 < 8; ++d0) { const float* wp = qnw + d0 * 16 + hi * 8;
#pragma unroll
      for (int e = 0; e < 8; ++e) { x[d0][e] *= rstd * wp[e]; n2 += x[d0][e] * x[d0][e]; } }
    { auto rr = __builtin_amdgcn_permlane32_swap(__float_as_uint(n2), __float_as_uint(n2), false, false); n2 = __uint_as_float(rr[0]) + __uint_as_float(rr[1]); }
    float kwm = fmaxf(fabsf(knw[2 * lane]), fabsf(knw[2 * lane + 1]));
#pragma unroll
    for (int o_ = 1; o_ < 64; o_ <<= 1) kwm = fmaxf(kwm, __shfl_xor(kwm, o_));
    const float mref = fminf(sqrtf(n2) * QSCALE * 11.313708499f * kwm * 1.0005f, 60.f);
#pragma unroll
    for (int r = 0; r < 16; ++r) negm[r] = -mref;
    asm volatile("" : "+v"(negm));
#pragma unroll
    for (int half = 0; half < 2; ++half) { const int pos = half ? (t & 63) : (t >> 6);
#pragma unroll
      for (int b = 0; b < 2; ++b) { const float* tp = tab + (pos * 32 + b * 16 + hi * 8) * 2;
#pragma unroll
        for (int e = 0; e < 8; ++e) { const float c = tp[2 * e], sn = tp[2 * e + 1]; const float x1 = x[half * 4 + b][e], x2 = x[half * 4 + b + 2][e];
          x[half * 4 + b][e] = (x1 * c - x2 * sn) * QSCALE; x[half * 4 + b + 2][e] = (x2 * c + x1 * sn) * QSCALE; } } }
#pragma unroll
    for (int d0 = 0; d0 < 8; ++d0) { u32x4 w = {cvtpk(x[d0][0], x[d0][1]), cvtpk(x[d0][2], x[d0][3]), cvtpk(x[d0][4], x[d0][5]), cvtpk(x[d0][6], x[d0][7])}; qr[d0] = *reinterpret_cast<bf16x8*>(&w); }
  }
  const int vb0 = (int)(uintptr_t)V_lds + v_rd_base(lane);
  unsigned koff, voff;
  { const int d0 = wid >> 1, row = (wid & 1) * 32 + (lane >> 1), h_ = lane & 1; koff = (unsigned)(row * LDK + d0 * 16 + h_ * 8) * 2u; }
  { const int sub = wid * 2 + (lane >> 5), kk = (sub >> 2) * 8 + ((lane & 31) >> 2), c = (sub & 3) * 32 + (lane & 3) * 8;
    const int k = (kk & ~0xC) | ((kk & 4) << 1) | ((kk & 8) >> 1); voff = (unsigned)(k * LDK + c) * 2u; }
  const __attribute__((address_space(3))) char* kdst = (const __attribute__((address_space(3))) char*)(unsigned)(uintptr_t)(K_lds + wid * 1024);
  const __attribute__((address_space(3))) char* vdst = (const __attribute__((address_space(3))) char*)(unsigned)(uintptr_t)(V_lds + wid * 1024);
#define DMA(k0, off) do { const char* kt_ = (const char*)Kh + (size_t)(k0) * (LDK * 2); const char* vt_ = (const char*)Vh + (size_t)(k0) * (LDK * 2); \
      __builtin_amdgcn_global_load_lds((const unsigned*)(kt_ + koff), (lds_u32*)(kdst + (off)), 16, 0, 0); \
      __builtin_amdgcn_global_load_lds((const unsigned*)(kt_ + 128 + koff), (lds_u32*)(kdst + (off) + 8192), 16, 0, 0); \
      __builtin_amdgcn_global_load_lds((const unsigned*)(vt_ + voff), (lds_u32*)(vdst + (off)), 16, 0, 0); \
      __builtin_amdgcn_global_load_lds((const unsigned*)(vt_ + 32 * LDK * 2 + voff), (lds_u32*)(vdst + (off) + 8192), 16, 0, 0); } while (0)
#define VWAIT() asm volatile("s_waitcnt vmcnt(0)" ::: "memory")
#define ROT() do { const int t_ = sl_prev; sl_prev = sl_cur; sl_cur = sl_n1; sl_n1 = sl_n2; sl_n2 = t_; } while (0)
#define WAITBAR(N) asm volatile("s_waitcnt vmcnt(" #N ") lgkmcnt(0)\n\ts_barrier" ::: "memory")
  f32x16 pA0, pA1, pB0, pB1; bf16x8 pa0, pa1, pa2, pa3; const int NT = seq / KVBLK;
  DMA(0, 0); DMA(KVBLK, (int)SHM_K); DMA(2 * KVBLK, 2 * (int)SHM_K); WAITBAR(4);
  qkt(pA0, pA1, (const bf16*)K_lds, qr, negm, r32, hi); partialSM(pA0);
  int sl_prev = 0, sl_cur = (int)SHM_K, sl_n1 = 2 * (int)SHM_K, sl_n2 = 3 * (int)SHM_K;
#define STEP(PC0, PC1, PP0, PP1, LD, jn2) do { \
    if (LD) { DMA((jn2) * KVBLK, sl_n2); } SBAR(); \
    qkt(PC0, PC1, (const bf16*)(K_lds + sl_cur), qr, negm, r32, hi); \
    finishSM(PP0, PP1, l_reg, pa0, pa1, pa2, pa3); SBAR(); \
    pv_d0(o, vb0 + sl_prev, pa0, pa1, pa2, pa3); partialSM(PC0); \
    if (LD) { WAITBAR(4); } else { WAITBAR(0); } ROT(); } while (0)
  int j = 1;
  for (; j + 4 < NT; j += 2) {
    STEP(pB0, pB1, pA0, pA1, true, j + 2);
    STEP(pA0, pA1, pB0, pB1, true, j + 3);
  }
  STEP(pB0, pB1, pA0, pA1, true, j + 2);
  STEP(pA0, pA1, pB0, pB1, false, 0);
  STEP(pB0, pB1, pA0, pA1, false, 0);
  finishSM(pB0, pB1, l_reg, pa0, pa1, pa2, pa3); SBAR();
  pv_d0(o, vb0 + sl_prev, pa0, pa1, pa2, pa3);
  if (hi == 0) li_l[r32] = l_reg; asm volatile("s_waitcnt lgkmcnt(0)" ::: "memory");
  float rli[16];
#pragma unroll
  for (int r = 0; r < 16; ++r) rli[r] = __builtin_amdgcn_rcpf(li_l[crow(r, hi)]);
  float* Ow = Ob + (long)(wid * QBLK) * LDO;
#pragma unroll
  for (int r = 0; r < 16; ++r) { int orow = crow(r, hi);
    for (int d0 = 0; d0 < 4; ++d0) Ow[(long)orow * LDO + d0 * 32 + r32] = o[d0][r] * rli[r]; }
#undef DMA
#undef VWAIT
#undef ROT
#undef WAITBAR
#undef STEP
}
#undef KSWZ
#undef SBAR
}
constexpr int M = 16384, DM = 2048, NIN = 4608, AW = 1024, LW = 1024, MIXW = 2048;
constexpr int C_Q = 0, C_K = 1024, C_V = 1280, C_GA = 1536, C_XR = 2560, C_GL = 3584;
constexpr float EPS = 1e-6f;
constexpr int NTHREADS = 512, NWAVES = 8;
constexpr int LDS_BYTES = 135168;
constexpr size_t MiB = 1u << 20;
constexpr size_t WS_WIN = 2 * MiB;
constexpr size_t WS_WOUT = 20 * MiB;
constexpr size_t WS_WG = 28 * MiB;
constexpr size_t WS_TAB = 29 * MiB;
constexpr size_t WS_CARRY = 31 * MiB;
constexpr size_t WS_SUMM = 30 * MiB;
constexpr size_t WS_XN = 32 * MiB;
constexpr size_t WS_PROJ = 96 * MiB;
constexpr size_t WS_O = 240 * MiB;
constexpr size_t WS_HF = 304 * MiB;
constexpr size_t WS_HB = 368 * MiB;
constexpr size_t WS_END = 432 * MiB;

#define LAS __attribute__((address_space(3)))
typedef unsigned short bf16r;
typedef float f32x4 __attribute__((ext_vector_type(4)));
typedef float f32x2 __attribute__((ext_vector_type(2)));
typedef float f32x16 __attribute__((ext_vector_type(16)));
typedef unsigned u32x4 __attribute__((ext_vector_type(4)));
typedef unsigned u32x2 __attribute__((ext_vector_type(2)));
typedef short bf16x8 __attribute__((ext_vector_type(8)));

__device__ __forceinline__ unsigned pk2(float lo, float hi) { unsigned r; asm volatile("v_cvt_pk_bf16_f32 %0, %1, %2" : "=v"(r) : "v"(lo), "v"(hi)); return r; }
__device__ __forceinline__ float bflo(unsigned v) { return __uint_as_float(v << 16); }
__device__ __forceinline__ float bfhi(unsigned v) { return __uint_as_float(v & 0xffff0000u); }
__device__ __forceinline__ float wave_sum(float v) {
#pragma unroll
    for (int o = 1; o < 64; o <<= 1) v += __shfl_xor(v, o);
    return v;
}
__device__ __forceinline__ float sigmoidf_(float z) { return __builtin_amdgcn_rcpf(1.f + __expf(-z)); }

struct Args { const float* in[15]; float* out; unsigned char* ws; int ph_lo, ph_hi; };
enum { I_X = 0, I_NORMW, I_WIN, I_QNW, I_KNW, I_CONVW, I_CONVB, I_WA, I_BA, I_WX, I_BX, I_LAM, I_ANW, I_LNW, I_WOUT };

__device__ __forceinline__ void transpose_item(const float* W, int ldw, int nblk, bf16r* WT, int ldo, LAS float* scr, int item, int lane) {
    const int kb = item / nblk, nb = item % nblk, k0 = 64 * kb, n0 = 32 * nb;
#pragma unroll 8
    for (int i = 0; i < 32; ++i) { const int kk = 2 * i + (lane >> 5); scr[kk * 33 + (lane & 31)] = __builtin_nontemporal_load(W + (size_t)(k0 + kk) * ldw + n0 + (lane & 31)); }
    asm volatile("s_waitcnt lgkmcnt(0)" ::: "memory");
    const int c = lane & 7;
#pragma unroll
    for (int j = 0; j < 4; ++j) { const int n = (lane >> 3) + 8 * j; const LAS float* s = scr + (8 * c) * 33 + n;
        u32x4 o; o.x = pk2(s[0 * 33], s[1 * 33]); o.y = pk2(s[2 * 33], s[3 * 33]); o.z = pk2(s[4 * 33], s[5 * 33]); o.w = pk2(s[6 * 33], s[7 * 33]);
        *(u32x4*)(WT + (size_t)(n0 + n) * ldo + k0 + 8 * c) = o; }
    asm volatile("s_waitcnt lgkmcnt(0)" ::: "memory");
}
__device__ __forceinline__ void p0_prologue(const Args& a, LAS unsigned char* lds, int gw, int NGW, int lane, int wave) {
    unsigned char* ws = a.ws;
    LAS float* scr = (LAS float*)(lds + wave * 16384);
    constexpr int I_IN = (DM / 64) * (NIN / 32), I_OUT = (MIXW / 64) * (DM / 32), I_G = 32 * 8;
    for (int it = gw; it < I_IN + I_OUT + I_G; it += NGW) {
        if (it < I_IN) transpose_item(a.in[I_WIN], NIN, NIN / 32, (bf16r*)(ws + WS_WIN), DM, scr, it, lane);
        else if (it < I_IN + I_OUT) transpose_item(a.in[I_WOUT], DM, DM / 32, (bf16r*)(ws + WS_WOUT), MIXW, scr, it - I_IN, lane);
        else { const int r = it - I_IN - I_OUT, mat = r >> 3, sub = r & 7, which = mat >> 4, db = mat & 15;
            const float* src = (which ? a.in[I_WX] : a.in[I_WA]) + (size_t)db * 128 * 128;
            bf16r* dst = (bf16r*)(ws + WS_WG) + (size_t)db * 256 * 128 + (size_t)which * 128 * 128;
            transpose_item(src, 128, 4, dst, 128, scr, sub, lane); }
    }
    { const int e = gw * 64 + lane;
      if (e < 256 * 32) { const int pos = e >> 5, i = e & 31;
        const float invf = __builtin_amdgcn_exp2f(-(float)i * 0.41524101186092029f);
        const float ang = (float)pos * invf;
        const double ad = (double)ang; const double k = __builtin_rint(ad * 0.63661977236758134);
        const double r = __builtin_fma(-k, 1.5707963267948966, ad); const double r2 = r * r;
        const double sn = r * (1.0 + r2 * (-1.0 / 6 + r2 * (1.0 / 120 + r2 * (-1.0 / 5040 + r2 * (1.0 / 362880 + r2 * (-1.0 / 39916800))))));
        const double cs = 1.0 + r2 * (-0.5 + r2 * (1.0 / 24 + r2 * (-1.0 / 720 + r2 * (1.0 / 40320 + r2 * (-1.0 / 3628800 + r2 * (1.0 / 479001600))))));
        const int q = ((int)k) & 3;
        const double c_ = (q == 0) ? cs : (q == 1) ? -sn : (q == 2) ? -cs : sn;
        const double s_ = (q == 0) ? sn : (q == 1) ? cs : (q == 2) ? -sn : -cs;
        f32x2 o; o.x = (float)c_; o.y = (float)s_; ((f32x2*)(ws + WS_TAB))[e] = o; } }
    const float* x = a.in[I_X]; const f32x4* nw = (const f32x4*)a.in[I_NORMW] + lane;
    for (int m = gw; m < M; m += NGW) {
        const f32x4* xr = (const f32x4*)(x + (size_t)m * DM) + lane; f32x4 v[8]; float s = 0.f;
#pragma unroll
        for (int j = 0; j < 8; ++j) { v[j] = __builtin_nontemporal_load(xr + 64 * j); s += (v[j].x * v[j].x + v[j].y * v[j].y) + (v[j].z * v[j].z + v[j].w * v[j].w); }
        const float rstd = rsqrtf(wave_sum(s) * (1.f / DM) + EPS);
        u32x2* o8 = (u32x2*)((bf16r*)(ws + WS_XN) + (size_t)m * DM) + lane;
#pragma unroll
        for (int j = 0; j < 8; ++j) { const f32x4 w = nw[64 * j]; u32x2 o; o.x = pk2(v[j].x * rstd * w.x, v[j].y * rstd * w.y); o.y = pk2(v[j].z * rstd * w.z, v[j].w * rstd * w.w); o8[64 * j] = o; }
    }
}

__device__ __forceinline__ void p2_qkprep(const Args& a, int gw, int NGW, int lane) {
    bf16r* proj = (bf16r*)(a.ws + WS_PROJ); const float* tab = (const float*)(a.ws + WS_TAB);
    const f32x2 kw = ((const f32x2*)a.in[I_KNW])[lane];
    const int i0 = (2 * lane) & 31; const float sgn = (lane & 16) ? 1.f : -1.f;
    for (int t0 = gw; t0 < M; t0 += 4 * NGW) {
        unsigned v[4][2]; f32x4 cs[4]; unsigned* rowp[4];
#pragma unroll
        for (int q = 0; q < 4; ++q) { const int t = min(t0 + q * NGW, M - 1); const int pos = (lane < 32) ? (t >> 6) : (t & 63);
            cs[q] = *(const f32x4*)(tab + (pos * 32 + i0) * 2);
            rowp[q] = (unsigned*)(proj + (size_t)t * NIN + C_K) + lane; v[q][0] = rowp[q][0]; v[q][1] = rowp[q][64]; }
#pragma unroll
        for (int q = 0; q < 4; ++q) { if (t0 + q * NGW >= M) break;
#pragma unroll
            for (int hh = 0; hh < 2; ++hh) {
                const float x0 = bflo(v[q][hh]), x1 = bfhi(v[q][hh]);
                const float rstd = rsqrtf(wave_sum(x0 * x0 + x1 * x1) * (1.f / 128.f) + EPS);
                const float y0 = x0 * rstd * kw.x, y1 = x1 * rstd * kw.y;
                const float p0 = __shfl_xor(y0, 16), p1 = __shfl_xor(y1, 16);
                rowp[q][hh * 64] = pk2(y0 * cs[q].x + sgn * p0 * cs[q].y, y1 * cs[q].z + sgn * p1 * cs[q].w); } }
    }
}

constexpr int L_SUM = 0, L_CW = 8192, L_WT = 16384;
#define KSWZ_(row, colB) ((row) * 256 + ((colB) ^ (((row) & 7) << 4)))
__device__ __forceinline__ int crow_(int r, int hi) { return (r & 3) + 8 * (r >> 2) + 4 * hi; }
template <int DIR>
__device__ __forceinline__ void lru_unit(const Args& a, LAS unsigned char* lds, int ck, int blk, bool load_w) {
    int tid = threadIdx.x; asm volatile("" : "+v"(tid));
    const int lane = tid & 63, r32 = lane & 31, hi = lane >> 5;
    const int w = __builtin_amdgcn_readfirstlane(tid >> 6);
    constexpr int d = DIR;
    unsigned char* ws = a.ws;
    const bf16r* proj = (const bf16r*)(ws + WS_PROJ);
    LAS float* CWl = (LAS float*)(lds + L_CW);
    LAS f32x2* SUM = (LAS f32x2*)(lds + L_SUM);
    __syncthreads();
    if (load_w) {
        const bf16r* Wt = (const bf16r*)(ws + WS_WG) + (size_t)(d * 8 + blk) * 256 * 128;
#pragma unroll
        for (int i = 0; i < 8; ++i) { const int p = tid + 512 * i, row = p >> 4, c16 = p & 15;
            const u32x4 v = *(const u32x4*)(Wt + row * 128 + c16 * 8); *(LAS u32x4*)(lds + L_WT + KSWZ_(row, c16 * 16)) = v; }
        const float* cw = a.in[I_CONVW]; const float* cbias = a.in[I_CONVB];
        for (int e = tid; e < 640; e += 512) CWl[e] = e < 512 ? cw[(e >> 7) * 1024 + blk * 128 + (e & 127)] : cbias[blk * 128 + (e - 512)];
    }
    __syncthreads();
    const int t = ck * 256 + w * 32 + r32;
    bf16x8 A[8];
#pragma unroll
    for (int kk = 0; kk < 8; ++kk) { const int c0 = kk * 16 + hi * 8;
        f32x4 acc0 = *(const LAS f32x4*)(CWl + 512 + c0), acc1 = *(const LAS f32x4*)(CWl + 512 + c0 + 4);
#pragma unroll
        for (int j = 0; j < 4; ++j) { const int tt = t + j - 2; const bool ok = tt >= 0 && tt < M; const int tc = ok ? tt : t;
            u32x4 xv = *(const u32x4*)(proj + (size_t)tc * NIN + C_XR + blk * 128 + c0);
            if (!ok) xv = (u32x4){0u, 0u, 0u, 0u};
            const f32x4 w0 = *(const LAS f32x4*)(CWl + j * 128 + c0), w1 = *(const LAS f32x4*)(CWl + j * 128 + c0 + 4);
            acc0.x += w0.x * bflo(xv.x); acc0.y += w0.y * bfhi(xv.x); acc0.z += w0.z * bflo(xv.y); acc0.w += w0.w * bfhi(xv.y);
            acc1.x += w1.x * bflo(xv.z); acc1.y += w1.y * bfhi(xv.z); acc1.z += w1.z * bflo(xv.w); acc1.w += w1.w * bfhi(xv.w); }
        u32x4 o; o.x = pk2(acc0.x, acc0.y); o.y = pk2(acc0.z, acc0.w); o.z = pk2(acc1.x, acc1.y); o.w = pk2(acc1.z, acc1.w);
        A[kk] = __builtin_bit_cast(bf16x8, o); if ((kk & 3) == 3) asm volatile("" ::: "memory"); }
    bf16x8 Bid[2];
#pragma unroll
    for (int kq = 0; kq < 2; ++kq)
#pragma unroll
        for (int j = 0; j < 8; ++j) Bid[kq][j] = (16 * kq + 8 * hi + j == r32) ? (short)0x3F80 : (short)0;
    unsigned* hcout = (unsigned*)(ws + (d ? WS_HB : WS_HF));
#pragma unroll
    for (int rd = 0; rd < 4; ++rd) {
        float hl[1][16], cq[1][16];
#pragma unroll
        for (int cc = 0; cc < 1; ++cc) { const int ct = rd + cc;
            f32x16 accr = {}, acci = {}, accx = {};
#pragma unroll
            for (int kk = 0; kk < 8; ++kk) {
                const bf16x8 br = *(const LAS bf16x8*)(lds + L_WT + KSWZ_(ct * 32 + r32, (kk * 16 + hi * 8) * 2));
                const bf16x8 bi = *(const LAS bf16x8*)(lds + L_WT + KSWZ_(128 + ct * 32 + r32, (kk * 16 + hi * 8) * 2));
                accr = __builtin_amdgcn_mfma_f32_32x32x16_bf16(A[kk], br, accr, 0, 0, 0);
                acci = __builtin_amdgcn_mfma_f32_32x32x16_bf16(A[kk], bi, acci, 0, 0, 0);
            }
            accx = __builtin_amdgcn_mfma_f32_32x32x16_bf16(A[2 * ct], Bid[0], accx, 0, 0, 0);
            accx = __builtin_amdgcn_mfma_f32_32x32x16_bf16(A[2 * ct + 1], Bid[1], accx, 0, 0, 0);
            const int cidx = d * 1024 + blk * 128 + ct * 32 + r32;
            const float ba = a.in[I_BA][cidx], bx = a.in[I_BX][cidx], lam = a.in[I_LAM][cidx];
            const float sp8 = 8.f * log1pf(__expf(-lam));
            float av[16], bv[16];
#pragma unroll
            for (int r = 0; r < 16; ++r) {
                const float rg = __builtin_amdgcn_rcpf(1.f + __builtin_amdgcn_exp2f(-1.4426950408889634f * (accr[r] + ba)));
                const float ig = __builtin_amdgcn_rcpf(1.f + __builtin_amdgcn_exp2f(-1.4426950408889634f * (acci[r] + bx)));
                const float la = -sp8 * rg; const float aa = __builtin_amdgcn_exp2f(1.4426950408889634f * la);
                const float om = __builtin_fmaf(-aa, aa, 1.f);
                av[r] = aa; bv[r] = __builtin_amdgcn_sqrtf(om) * ig * accx[r];
            }
            float Pg[4], Hg[4];
#pragma unroll
            for (int g = 0; g < 4; ++g) { float h = 0.f, cp = 1.f;
#pragma unroll
                for (int e = 0; e < 4; ++e) { const int r = 4 * g + (DIR == 0 ? e : 3 - e); h = av[r] * h + bv[r]; cp *= av[r]; bv[r] = h; av[r] = cp; }
                Pg[g] = cp; Hg[g] = h; }
            float F = 1.f, E = 0.f, Fg[4], Eg[4];
#pragma unroll
            for (int gi = 0; gi < 4; ++gi) { const int g = DIR == 0 ? gi : 3 - gi;
                const float pP = __shfl_xor(Pg[g], 32), pH = __shfl_xor(Hg[g], 32);
                const float Pe = hi ? pP : Pg[g], He = hi ? pH : Hg[g];
                const float Po = hi ? Pg[g] : pP, Ho = hi ? Hg[g] : pH;
                if (DIR == 0) { const float F1 = Pe * F, E1 = Pe * E + He; Fg[g] = hi ? F1 : F; Eg[g] = hi ? E1 : E; F = Po * F1; E = Po * E1 + Ho; }
                else          { const float F1 = Po * F, E1 = Po * E + Ho; Fg[g] = hi ? F : F1; Eg[g] = hi ? E : E1; F = Pe * F1; E = Pe * E1 + He; } }
            if (hi == 0) { f32x2 o; o.x = F; o.y = E; SUM[(rd * 8 + w) * 32 + r32] = o; }
#pragma unroll
            for (int r = 0; r < 16; ++r) { hl[cc][r] = bv[r] + av[r] * Eg[r >> 2]; cq[cc][r] = av[r] * Fg[r >> 2]; }
        }
        __syncthreads();
        {
            const int ct = rd; float Fw = 1.f, Ew = 0.f;
            if (DIR == 0) { for (int wp = 0; wp < w; ++wp) { const f32x2 fe = SUM[(rd * 8 + wp) * 32 + r32]; Ew = fe.x * Ew + fe.y; Fw *= fe.x; } }
            else          { for (int wp = 7; wp > w; --wp) { const f32x2 fe = SUM[(rd * 8 + wp) * 32 + r32]; Ew = fe.x * Ew + fe.y; Fw *= fe.x; } }
            const size_t o0 = (size_t)(ck * 256 + w * 32) * LW + blk * 128 + ct * 32 + r32;
#pragma unroll
            for (int r = 0; r < 16; ++r) { const size_t oo = o0 + (size_t)crow_(r, hi) * LW;
                hcout[oo] = pk2(hl[0][r] + cq[0][r] * Ew, cq[0][r] * Fw); }
        }
        if (tid < 32) {
            float F = 1.f, E = 0.f;
#pragma unroll
            for (int wi = 0; wi < 8; ++wi) { const int wp = DIR == 0 ? wi : 7 - wi; const f32x2 fe = SUM[(rd * 8 + wp) * 32 + tid]; E = fe.x * E + fe.y; F *= fe.x; }
            f32x2 o; o.x = F; o.y = E; ((f32x2*)(ws + WS_SUMM))[(ck * 2 + d) * 1024 + blk * 128 + rd * 32 + tid] = o;
        }
    }
}
__device__ __forceinline__ void lru_phase(const Args& a, LAS unsigned char* lds, int bid, int G, int nrep) {
    const int key = bid & 15, d = key & 1, blk = key >> 1, ck0 = bid >> 4, dck = G >> 4;
    if (d == 0) { bool first = true; for (int c_ = ck0; c_ < 64 * nrep; c_ += dck) { lru_unit<0>(a, lds, c_ & 63, blk, first); first = false; } }
    else        { bool first = true; for (int c_ = ck0; c_ < 64 * nrep; c_ += dck) { lru_unit<1>(a, lds, c_ & 63, blk, first); first = false; } }
    __syncthreads();
}
__device__ __forceinline__ void carry_phase(const Args& a, int gw, int NGW, int lane) {
    const f32x2* summ = (const f32x2*)(a.ws + WS_SUMM); float* carry = (float*)(a.ws + WS_CARRY);
    for (int ch = gw; ch < 2048; ch += NGW) { const int d = ch >> 10, c = ch & 1023, kk = d ? 63 - lane : lane;
        const f32x2 s = summ[(kk * 2 + d) * 1024 + c]; float P = s.x, H = s.y;
#pragma unroll
        for (int off = 1; off < 64; off <<= 1) { const float Pp = __shfl_up(P, off), Hp = __shfl_up(H, off); if (lane >= off) { H = P * Hp + H; P = P * Pp; } }
        const float cin = __shfl_up(H, 1);
        carry[(kk * 2 + d) * 1024 + c] = lane ? cin : 0.f; }
}

__device__ __forceinline__ void p4_mix(const Args& a, int gw, int NGW, int lane) {
    unsigned char* ws = a.ws;
    const bf16r* proj = (const bf16r*)(ws + WS_PROJ); bf16r* mixed = (bf16r*)(ws + WS_XN);
    const float* O = (const float*)(ws + WS_O);
    const unsigned* HCF = (const unsigned*)(ws + WS_HF); const unsigned* HCB = (const unsigned*)(ws + WS_HB);
    const float* carry = (const float*)(ws + WS_CARRY);
    const f32x4* anw = (const f32x4*)a.in[I_ANW] + lane; const f32x4* lnw = (const f32x4*)a.in[I_LNW] + lane;
    for (int b8 = gw; b8 < M / 8; b8 += NGW) {
        const int ck = b8 >> 5; f32x4 cf[4], cb[4];
#pragma unroll
        for (int j = 0; j < 4; ++j) { cf[j] = ((const f32x4*)(carry + (ck * 2 + 0) * 1024) + lane)[64 * j]; cb[j] = ((const f32x4*)(carry + (ck * 2 + 1) * 1024) + lane)[64 * j]; }
        for (int rr = 0; rr < 8; ++rr) { const int m = b8 * 8 + rr;
        f32x4 v[4], u[4]; float s1 = 0.f, s2 = 0.f;
#pragma unroll
        for (int j = 0; j < 4; ++j) {
            v[j] = __builtin_nontemporal_load((const f32x4*)(O + (size_t)m * AW) + lane + 64 * j);
            const u32x4 f = __builtin_nontemporal_load((const u32x4*)(HCF + (size_t)m * LW) + lane + 64 * j), b = __builtin_nontemporal_load((const u32x4*)(HCB + (size_t)m * LW) + lane + 64 * j);
            u[j].x = (bflo(f.x) + bfhi(f.x) * cf[j].x) + (bflo(b.x) + bfhi(b.x) * cb[j].x);
            u[j].y = (bflo(f.y) + bfhi(f.y) * cf[j].y) + (bflo(b.y) + bfhi(b.y) * cb[j].y);
            u[j].z = (bflo(f.z) + bfhi(f.z) * cf[j].z) + (bflo(b.z) + bfhi(b.z) * cb[j].z);
            u[j].w = (bflo(f.w) + bfhi(f.w) * cf[j].w) + (bflo(b.w) + bfhi(b.w) * cb[j].w);
            s1 += (v[j].x * v[j].x + v[j].y * v[j].y) + (v[j].z * v[j].z + v[j].w * v[j].w);
            s2 += (u[j].x * u[j].x + u[j].y * u[j].y) + (u[j].z * u[j].z + u[j].w * u[j].w); }
        const float r1 = rsqrtf(wave_sum(s1) * (1.f / AW) + EPS), r2 = rsqrtf(wave_sum(s2) * (1.f / LW) + EPS);
        const u32x2* ga = (const u32x2*)(proj + (size_t)m * NIN + C_GA) + lane; const u32x2* gl = (const u32x2*)(proj + (size_t)m * NIN + C_GL) + lane;
        u32x2* mo = (u32x2*)(mixed + (size_t)m * MIXW) + lane;
#pragma unroll
        for (int j = 0; j < 4; ++j) {
            { const u32x2 g = __builtin_nontemporal_load(ga + 64 * j); const f32x4 w = anw[64 * j];
              const float g0 = bflo(g.x), g1 = bfhi(g.x), g2 = bflo(g.y), g3 = bfhi(g.y);
              u32x2 o; o.x = pk2(v[j].x * r1 * w.x * g0 * sigmoidf_(g0), v[j].y * r1 * w.y * g1 * sigmoidf_(g1));
              o.y = pk2(v[j].z * r1 * w.z * g2 * sigmoidf_(g2), v[j].w * r1 * w.w * g3 * sigmoidf_(g3)); mo[64 * j] = o; }
            { const u32x2 g = __builtin_nontemporal_load(gl + 64 * j); const f32x4 w = lnw[64 * j];
              const float g0 = bflo(g.x), g1 = bfhi(g.x), g2 = bflo(g.y), g3 = bfhi(g.y);
              u32x2 o; o.x = pk2(u[j].x * r2 * w.x * g0 * sigmoidf_(g0), u[j].y * r2 * w.y * g1 * sigmoidf_(g1));
              o.y = pk2(u[j].z * r2 * w.z * g2 * sigmoidf_(g2), u[j].w * r2 * w.w * g3 * sigmoidf_(g3)); mo[256 + 64 * j] = o; }
        }
        }
    }
}

#define RLX_AGENT __ATOMIC_RELAXED, __HIP_MEMORY_SCOPE_AGENT
#define XB_TMO      128
#define XB_XCNT(j)  (256  + 64 * (j))
#define XB_XSUB(j)  (1280 + 64 * (j))
#define XB_XGEN(j)  (2304 + 64 * (j))
#define XB_TOP      3328
#define XB_TOPGEN   3392
#define XCD_BAR_WORDS 3456
#define XB_SPIN_CAP (1u << 18)

__device__ __forceinline__ unsigned xb_ld(unsigned* p)              { return __hip_atomic_load(p, __ATOMIC_RELAXED, __HIP_MEMORY_SCOPE_AGENT); }
__device__ __forceinline__ unsigned xb_add(unsigned* p, unsigned v) { return __hip_atomic_fetch_add(p, v, __ATOMIC_RELAXED, __HIP_MEMORY_SCOPE_AGENT); }
__device__ __forceinline__ unsigned xb_xcc_id() { return (unsigned)__builtin_amdgcn_s_getreg((3 << 11) | 20) & 0xFu; }
#define XB_SPIN(cond, bar) do { unsigned _sp = 0; while (cond) { __builtin_amdgcn_s_sleep(1); \
    if ((++_sp & 255u) == 0u) { if (xb_ld(&(bar)[XB_TMO])) break; if (_sp > XB_SPIN_CAP) { atomicAdd(&(bar)[XB_TMO], 1u); break; } } } } while (0)

struct XcdBarrier {
    unsigned* bar; unsigned x;
    volatile LAS unsigned* st;
};

__device__ __forceinline__ XcdBarrier xcd_barrier_post(unsigned* bar, volatile LAS unsigned* st) {
    XcdBarrier b; b.bar = bar; b.x = xb_xcc_id(); b.st = st;
    if (threadIdx.x == 0) (void)xb_add(&bar[XB_XCNT(b.x)], 1u);
    return b;
}
__device__ __forceinline__ void xcd_barrier_complete(unsigned* bar, unsigned x, unsigned& nloc, unsigned& nx) {
    const unsigned G = gridDim.x * gridDim.y * gridDim.z;
    unsigned sum, cnt, mine, sp = 0u;
    for (;;) {
        sum = 0u; cnt = 0u; mine = 0u;
#pragma unroll
        for (unsigned j = 0; j < 16; ++j) { const unsigned c = xb_ld(&bar[XB_XCNT(j)]); sum += c; cnt += (c > 0u) ? 1u : 0u; mine = (j == x) ? c : mine; }
        if (sum == G) break;
        __builtin_amdgcn_s_sleep(1);
        if ((++sp & 255u) == 0u) { if (xb_ld(&bar[XB_TMO])) break; if (sp > XB_SPIN_CAP) { atomicAdd(&bar[XB_TMO], 1u); break; } }
    }
    nloc = mine > 0u ? mine : 1u; nx = cnt > 0u ? cnt : 1u;
}

__device__ __forceinline__ void xcd_barrier(const XcdBarrier& b) {
    asm volatile("s_waitcnt vmcnt(0)" ::: "memory");
    __syncthreads();
    if (threadIdx.x == 0) {
        unsigned* bar = b.bar;
        __builtin_amdgcn_s_waitcnt(0);
        unsigned nloc = b.st[0], nx = b.st[1];
        if (nloc == 0u) { xcd_barrier_complete(bar, b.x, nloc, nx); b.st[0] = nloc; b.st[1] = nx; }
        const unsigned old = xb_add(&bar[XB_XSUB(b.x)], 1u);
        const unsigned gen = old / nloc;
        if (old + 1u == (gen + 1u) * nloc) {
            __builtin_amdgcn_fence(__ATOMIC_RELEASE, "agent");
            asm volatile("s_waitcnt vmcnt(0)" ::: "memory");
            const unsigned og = xb_add(&bar[XB_TOP], 1u);
            const unsigned tg = og / nx;
            if (og + 1u == (tg + 1u) * nx) xb_add(&bar[XB_TOPGEN], 1u);
            else XB_SPIN(xb_ld(&bar[XB_TOPGEN]) == tg, bar);
            __builtin_amdgcn_fence(__ATOMIC_ACQUIRE, "agent");
            xb_add(&bar[XB_XGEN(b.x)], 1u);
            asm volatile("s_waitcnt vmcnt(0)" ::: "memory");
        } else {
            XB_SPIN(xb_ld(&bar[XB_XGEN(b.x)]) == gen, bar);
            __builtin_amdgcn_fence(__ATOMIC_ACQUIRE, "agent");
            asm volatile("s_waitcnt vmcnt(0)" ::: "memory");
        }
    }
    __syncthreads();
}

__global__ void __launch_bounds__(NTHREADS) hybrid_fwd(Args args) {
    extern __shared__ __attribute__((aligned(16))) unsigned char lds_raw[];
    LAS unsigned char* lds = (LAS unsigned char*)lds_raw;
    __shared__ __attribute__((aligned(16))) unsigned xb_st[4];
    cg::grid_group grid = cg::this_grid();
    const int tid = threadIdx.x, lane = tid & 63, wave = __builtin_amdgcn_readfirstlane(tid >> 6);
    if (tid < 4) xb_st[tid] = 0u;
    __syncthreads();
    const XcdBarrier xbar = xcd_barrier_post((unsigned*)args.ws, (volatile LAS unsigned*)xb_st);
    const int G = gridDim.x, bid = blockIdx.x;
    const int gw = bid * NWAVES + wave, NGW = G * NWAVES;
    unsigned char* ws = args.ws;
    const int lo = args.ph_lo, hi = args.ph_hi;
#define IN(k) (lo <= (k) && (k) < hi)
#ifndef REP
#define REP -1
#endif
#define NREP(k) ((REP) == (k) ? 2 : 1)
#define SEAM(k) do { if (IN(k) && IN((k) + 1)) xcd_barrier(xbar); } while (0)
    if (lo > hi) grid.sync();

    if (IN(0)) { p0_prologue(args, lds, gw, NGW, lane, wave); __syncthreads(); }
    SEAM(0);
    if (IN(1)) {
        pg8::Gemm g{(const pg8::bf16_t*)(ws + WS_XN), (const pg8::bf16_t*)(ws + WS_WIN), M, NIN, DM}; pg8::StaticOrder S; S.init(M, NIN, G, bid);
        pg8::EpiStoreBf16 E{(pg8::bf16_t*)(ws + WS_PROJ), NIN};
        pg8::gemm_phase<pg8::EpiStoreBf16, pg8::StaticOrder, true, true>(lds, g, S, E);
        __syncthreads();
    }
    SEAM(1);
    if (IN(2)) p2_qkprep(args, gw, NGW, lane);
    SEAM(2);
    if (IN(3)) {
        const att::bf16* proj = (const att::bf16*)(ws + WS_PROJ);
        for (int u = bid; u < 512; u += G) { const int h = u >> 6, qb = u & 63, kvh = h >> 2;
            att::attn_dense_body<att::bf16>(proj + (size_t)qb * 256 * NIN + C_Q + h * 128, proj + C_K + kvh * 128, proj + C_V + kvh * 128,
                                            (float*)(ws + WS_O) + (size_t)qb * 256 * AW + h * 128, M, (char*)lds_raw, args.in[I_QNW], args.in[I_KNW], (const float*)(ws + WS_TAB), qb * 256);
            __syncthreads(); }
        lru_phase(args, lds, bid, G, 1);
    }
    SEAM(3);
    if (IN(4)) carry_phase(args, gw, NGW, lane);
    SEAM(4);
    if (IN(5)) p4_mix(args, gw, NGW, lane);
    SEAM(5);
    if (IN(6)) {
        pg8::Gemm g{(const pg8::bf16_t*)(ws + WS_XN), (const pg8::bf16_t*)(ws + WS_WOUT), M, DM, MIXW}; pg8::StaticOrder S; S.init(M, DM, G, bid);
        pg8::EpiResidual E{args.in[I_X], args.out, DM};
        pg8::gemm_phase<pg8::EpiResidual, pg8::StaticOrder, true, true>(lds, g, S, E);
    }
#undef IN
#undef SEAM
}

#ifndef N_LAUNCHES
#define N_LAUNCHES 1
#endif
extern "C" void kernel_launch(void* const* d_in, const int* in_sizes, int n_in, void* d_out, int out_size, void* d_ws, size_t ws_size, hipStream_t stream) {
    static int grid = 0;
    if (grid == 0) {
        if (n_in != 15 || in_sizes[0] != M * DM || out_size != M * DM || ws_size < WS_END) { fprintf(stderr, "kernel_launch: shape/workspace mismatch (n_in %d, ws %zu)\n", n_in, ws_size); grid = -1; return; }
        int dev = 0, cus = 0, per_cu = 0;
        (void)hipGetDevice(&dev); (void)hipDeviceGetAttribute(&cus, hipDeviceAttributeMultiprocessorCount, dev);
        if (hipFuncSetAttribute((const void*)hybrid_fwd, hipFuncAttributeMaxDynamicSharedMemorySize, LDS_BYTES) != hipSuccess) { fprintf(stderr, "kernel_launch: hipFuncSetAttribute failed\n"); grid = -1; return; }
        if (hipOccupancyMaxActiveBlocksPerMultiprocessor(&per_cu, (const void*)hybrid_fwd, NTHREADS, LDS_BYTES) != hipSuccess || per_cu < 1) { fprintf(stderr, "kernel_launch: occupancy query gave %d\n", per_cu); per_cu = 1; }
        (void)hipGetLastError();
        grid = cus * 1;
    }
    if (grid < 0) return;
    Args a{};
    for (int i = 0; i < 15; ++i) a.in[i] = (const float*)d_in[i];
    a.out = (float*)d_out; a.ws = (unsigned char*)d_ws;
    if (hipMemsetAsync(d_ws, 0, 16384, stream) != hipSuccess) { fprintf(stderr, "kernel_launch: hipMemsetAsync failed\n"); return; }
    if (N_LAUNCHES == 1) {
        a.ph_lo = 0; a.ph_hi = 7;
        void* kargs[] = {&a};
        hipError_t e = hipLaunchCooperativeKernel((const void*)hybrid_fwd, dim3(grid), dim3(NTHREADS), kargs, LDS_BYTES, stream);
        if (e != hipSuccess) fprintf(stderr, "cooperative launch failed: %s (grid %d)\n", hipGetErrorString(e), grid);
    } else {
        for (int p = 0; p < 7; ++p) { a.ph_lo = p; a.ph_hi = p + 1; hipLaunchKernelGGL(hybrid_fwd, dim3(grid), dim3(NTHREADS), LDS_BYTES, stream, a); }
    }
}
```

```cpp
#include <hip/hip_runtime.h>
#include <hip/hip_bf16.h>
#include <hip/hip_cooperative_groups.h>
#include <cstdio>
#include <cstdint>
namespace cg = cooperative_groups;
namespace pg8 {
#define PG8_LAS __attribute__((address_space(3)))
typedef unsigned short bf16_t;
typedef short bf16x8 __attribute__((ext_vector_type(8)));
typedef float f32x4 __attribute__((ext_vector_type(4)));
typedef unsigned u32x4 __attribute__((ext_vector_type(4)));
constexpr int BM = 256, BK = 64, HALF = 128, HTB = HALF * BK * 2  , STAGE_BYTES = 8 * HTB, NXCD = 8, WGM = 8;

__host__ __device__ __forceinline__ int lds_byte(int r, int c) { const int st = (r >> 4) * 2 + (c >> 5), rr = r & 15, cc = c & 31, ob = rr * 64 + cc * 2; return st * 1024 + (ob ^ (((ob >> 9) & 1) << 5)); }
__host__ __device__ __forceinline__ void stage_rc(int b, int& R, int& C) { const int st = b / 1024, sb = b % 1024, swz = sb ^ (((sb >> 9) & 1) << 5); R = (st >> 1) * 16 + swz / 64; C = (st & 1) * 32 + (swz % 64) / 2; }
__host__ __device__ __forceinline__ int perm32(int rho) { const int n = rho >> 4, i = rho & 15; return 8 * (i >> 2) + 4 * n + (i & 3); }

struct Unit { int pm, pn; };
struct Gemm { const bf16_t* A; const bf16_t* Bt; int M, N, K; };

struct StaticOrder {
    int nM, nN, nwg, G, c;
    __host__ __device__ void init(int M, int N, int G_, int c_) { nM = M / BM; nN = N / BM; nwg = nM * nN; G = G_; c = c_; }
    __host__ __device__ bool next(int i, Unit& u) const {
        const long L = (long)i * G + c; if (L >= nwg) return false;
        int wgid = (int)L; { const int q = nwg / NXCD, r = nwg % NXCD, xcd = wgid % NXCD, off = wgid / NXCD; wgid = (xcd < r ? xcd * (q + 1) : r * (q + 1) + (xcd - r) * q) + off; }
        const int nig = WGM * nN, gid = wgid / nig, fm = gid * WGM, gsz = (nM - fm) < WGM ? (nM - fm) : WGM;
        u.pm = fm + ((wgid % nig) % gsz); u.pn = (wgid % nig) / gsz; return true;
    }
    __device__ __forceinline__ void a_ready(const Unit&) const {}
    __device__ __forceinline__ void done(const Unit&) const {}
};

__device__ __forceinline__ unsigned cvt_pk_bf16(float lo, float hi) { unsigned r; asm volatile("v_cvt_pk_bf16_f32 %0, %1, %2" : "=v"(r) : "v"(lo), "v"(hi)); return r; }
__device__ __forceinline__ void store16_wt(void* p, u32x4 v) { asm volatile("global_store_dwordx4 %0, %1, off sc1" :: "v"(p), "v"(v) : "memory"); }
struct EpiStoreBf16 {
    static constexpr bool PERM = true, AFTER_DRAIN = false;
    bf16_t* O; int ldc;
    __device__ __forceinline__ void operator()(const f32x4 (&acc)[2][2][4][2], const Unit& u, int wr, int wc, int fr, int fq) const {
        const int row0 = u.pm * BM + wr * 64 + fr; const int col0 = u.pn * BM + wc * 32 + 8 * fq;
#pragma unroll
        for (int ai = 0; ai < 2; ++ai)
#pragma unroll
            for (int m = 0; m < 4; ++m) { bf16_t* rowp = O + (size_t)(row0 + ai * HALF + m * 16) * ldc + col0;
#pragma unroll
                for (int bj = 0; bj < 2; ++bj) { const f32x4 v0 = acc[ai][bj][m][0], v1 = acc[ai][bj][m][1];
                    u32x4 w; w.x = cvt_pk_bf16(v0[0], v0[1]); w.y = cvt_pk_bf16(v0[2], v0[3]); w.z = cvt_pk_bf16(v1[0], v1[1]); w.w = cvt_pk_bf16(v1[2], v1[3]);
                    store16_wt(rowp + bj * HALF, w); } }
    }
};
struct EpiResidual {
    static constexpr bool PERM = false, AFTER_DRAIN = false;
    const float* x; float* out; int ldc;
    __device__ __forceinline__ void operator()(const f32x4 (&acc)[2][2][4][2], const Unit& u, int wr, int wc, int fr, int fq) const {
        const int row0 = u.pm * BM + wr * 64 + fr; const int col0 = u.pn * BM + wc * 32 + 4 * fq;
#pragma unroll
        for (int ai = 0; ai < 2; ++ai)
#pragma unroll
            for (int m = 0; m < 4; ++m) { const size_t off = (size_t)(row0 + ai * HALF + m * 16) * ldc + col0;
#pragma unroll
                for (int bj = 0; bj < 2; ++bj)
#pragma unroll
                    for (int n = 0; n < 2; ++n) { const f32x4 xv = *(const f32x4*)(x + off + bj * HALF + n * 16); *(f32x4*)(out + off + bj * HALF + n * 16) = xv + acc[ai][bj][m][n]; } }
    }
};
template <class Epi, class Sched, bool ALIGN_EPI = false, bool SP2 = false>
__device__ __forceinline__ void gemm_phase(PG8_LAS unsigned char* lds, const Gemm g, const Sched& S, const Epi& E) {
    const int tid = threadIdx.x, wid = __builtin_amdgcn_readfirstlane(tid >> 6), lane = tid & 63, wr = wid >> 2, wc = wid & 3, fr = lane & 15, fq = lane >> 4;
    const int K = g.K, nt = K / BK;
    unsigned voffA[2], voffB[2];
#pragma unroll
    for (int i = 0; i < 2; ++i) { int R, C; stage_rc(tid * 16 + i * 8192, R, C); const int Rb = Epi::PERM ? ((R & ~31) + perm32(R & 31)) : R;
        voffA[i] = (unsigned)(R * K + C) * 2u; voffB[i] = (unsigned)(Rb * K + C) * 2u; }
    const size_t kstep = (size_t)(BK * 2);
    const size_t hstep = (size_t)HALF * K * 2;
    const size_t tstep = 2 * hstep;
    const unsigned ldsw = (unsigned)wid * 1024u;
    const int aoff = lds_byte(wr * 64 + fr, fq * 8), boff = lds_byte(wc * 32 + fr, fq * 8);
#define PG8_SA(b, h) (((b) * 2 + (h)) * HTB)
#define PG8_SB(b, h) ((4 + (b) * 2 + (h)) * HTB)
#define PG8_STAGE(bufoff, gbase, voff) do { _Pragma("unroll") for (int _i = 0; _i < 2; ++_i) \
        __builtin_amdgcn_global_load_lds((const unsigned*)((const char*)(gbase) + (voff)[_i]), (PG8_LAS unsigned*)(lds + (bufoff) + ldsw + _i * 8192), 16, 0, 0); } while (0)
#define PG8_LDA(dst, b, h) do { _Pragma("unroll") for (int m = 0; m < 4; ++m) _Pragma("unroll") for (int k = 0; k < 2; ++k) dst[m][k] = *(const PG8_LAS bf16x8*)(lds + PG8_SA(b, h) + aoff + m * 2048 + k * 1024); } while (0)
#define PG8_LDB(dst, b, h) do { _Pragma("unroll") for (int n = 0; n < 2; ++n) _Pragma("unroll") for (int k = 0; k < 2; ++k) dst[n][k] = *(const PG8_LAS bf16x8*)(lds + PG8_SB(b, h) + boff + n * 2048 + k * 1024); } while (0)
#define PG8_MMA(ai, bj, At, Bt) do { __builtin_amdgcn_s_setprio(1); _Pragma("unroll") for (int m = 0; m < 4; ++m) _Pragma("unroll") for (int n = 0; n < 2; ++n) _Pragma("unroll") for (int k = 0; k < 2; ++k) \
        acc[ai][bj][m][n] = __builtin_amdgcn_mfma_f32_16x16x32_bf16(Bt[n][k], At[m][k], acc[ai][bj][m][n], 0, 0, 0); __builtin_amdgcn_s_setprio(0); } while (0)
#define PG8_WAIT_V(n) asm volatile("s_waitcnt vmcnt(" #n ")" ::: "memory")
#define PG8_WAIT_L(n) asm volatile("s_waitcnt lgkmcnt(" #n ")" ::: "memory")
#define PG8_BAR __builtin_amdgcn_s_barrier()
#define PG8_SCHED __builtin_amdgcn_sched_barrier(0)
    Unit cur, nxt; int ui = 0;
    if (!S.next(0, cur)) return;
    f32x4 acc[2][2][4][2];
#pragma unroll
    for (int a = 0; a < 2; ++a)
#pragma unroll
        for (int b = 0; b < 2; ++b)
#pragma unroll
            for (int m = 0; m < 4; ++m)
#pragma unroll
                for (int n = 0; n < 2; ++n) acc[a][b][m][n] = (f32x4){0.f, 0.f, 0.f, 0.f};
    bf16x8 At[4][2], B0[2][2], B1[2][2];
    const char* cA = (const char*)g.A + (size_t)cur.pm * tstep; const char* cB = (const char*)g.Bt + (size_t)cur.pn * tstep;
    S.a_ready(cur);
    if constexpr (SP2) {
        PG8_STAGE(PG8_SB(0, 0), cB, voffB); PG8_STAGE(PG8_SB(0, 1), cB + hstep, voffB); PG8_STAGE(PG8_SA(0, 0), cA, voffA); PG8_STAGE(PG8_SA(0, 1), cA + hstep, voffA);
        if (wr == 1) PG8_BAR;
        PG8_WAIT_V(2); PG8_BAR;
        PG8_STAGE(PG8_SB(1, 0), cB + kstep, voffB); PG8_STAGE(PG8_SA(1, 0), cA + kstep, voffA); PG8_STAGE(PG8_SB(1, 1), cB + hstep + kstep, voffB);
        PG8_WAIT_V(6); PG8_BAR;
    } else {
        PG8_STAGE(PG8_SB(0, 0), cB, voffB); PG8_STAGE(PG8_SA(0, 0), cA, voffA); PG8_STAGE(PG8_SB(0, 1), cB + hstep, voffB); PG8_STAGE(PG8_SA(0, 1), cA + hstep, voffA);
        if (wr == 1) PG8_BAR;
        PG8_WAIT_V(4); PG8_BAR;
        PG8_STAGE(PG8_SB(1, 0), cB + kstep, voffB); PG8_STAGE(PG8_SA(1, 0), cA + kstep, voffA); PG8_STAGE(PG8_SB(1, 1), cB + hstep + kstep, voffB);
        PG8_WAIT_V(6); PG8_BAR;
    }
    for (;;) {
        const bool has_next = S.next(ui + 1, nxt);
        const char* nA = has_next ? (const char*)g.A + (size_t)nxt.pm * tstep : cA; const char* nB = has_next ? (const char*)g.Bt + (size_t)nxt.pn * tstep : cB;
        for (int t = 0; t < nt; t += 2) {
            const bool last = (t == nt - 2);
            const char* a1 = cA + (size_t)(t + 1) * kstep;
            const char* a2 = last ? nA : cA + (size_t)(t + 2) * kstep; const char* b2 = last ? nB : cB + (size_t)(t + 2) * kstep;
            const char* a3 = a2 + kstep; const char* b3 = b2 + kstep;
            if (last && has_next) S.a_ready(nxt);
            if constexpr (SP2) {
            PG8_LDB(B0, 0, 0); PG8_LDB(B1, 0, 1); PG8_SCHED; PG8_LDA(At, 0, 0); PG8_STAGE(PG8_SA(1, 1), a1 + hstep, voffA);
            PG8_WAIT_V(8); PG8_WAIT_L(0); PG8_BAR; PG8_MMA(0, 0, At, B0); PG8_MMA(0, 1, At, B1); PG8_BAR; PG8_SCHED;
            PG8_LDA(At, 0, 1); PG8_STAGE(PG8_SB(0, 0), b2, voffB); PG8_STAGE(PG8_SB(0, 1), b2 + hstep, voffB); PG8_STAGE(PG8_SA(0, 0), a2, voffA);
            PG8_WAIT_V(8); PG8_WAIT_L(0); PG8_BAR; PG8_MMA(1, 0, At, B0); PG8_MMA(1, 1, At, B1); PG8_BAR; PG8_SCHED;
            PG8_LDB(B0, 1, 0); PG8_LDB(B1, 1, 1); PG8_SCHED; PG8_LDA(At, 1, 0); PG8_STAGE(PG8_SA(0, 1), a2 + hstep, voffA);
            PG8_WAIT_V(8); PG8_WAIT_L(0); PG8_BAR; PG8_MMA(0, 0, At, B0); PG8_MMA(0, 1, At, B1); PG8_BAR; PG8_SCHED;
            PG8_LDA(At, 1, 1); PG8_STAGE(PG8_SB(1, 0), b3, voffB); PG8_STAGE(PG8_SB(1, 1), b3 + hstep, voffB); PG8_STAGE(PG8_SA(1, 0), a3, voffA);
            PG8_WAIT_V(8); PG8_WAIT_L(0); PG8_BAR; PG8_MMA(1, 0, At, B0); PG8_MMA(1, 1, At, B1); PG8_BAR; PG8_SCHED;
            } else {
            PG8_LDB(B0, 0, 0); PG8_SCHED; PG8_LDA(At, 0, 0); PG8_STAGE(PG8_SA(1, 1), a1 + hstep, voffA);
            PG8_WAIT_L(8); PG8_BAR; PG8_WAIT_L(0); PG8_MMA(0, 0, At, B0); PG8_BAR; PG8_SCHED;
            PG8_LDB(B1, 0, 1); PG8_STAGE(PG8_SB(0, 0), b2, voffB);
            PG8_BAR; PG8_WAIT_L(0); PG8_MMA(0, 1, At, B1); PG8_BAR;
            PG8_LDA(At, 0, 1); PG8_STAGE(PG8_SA(0, 0), a2, voffA);
            PG8_BAR; PG8_WAIT_L(0); PG8_MMA(1, 0, At, B0); PG8_BAR; PG8_SCHED;
            PG8_STAGE(PG8_SB(0, 1), b2 + hstep, voffB);
            PG8_WAIT_V(6); PG8_BAR; PG8_MMA(1, 1, At, B1); PG8_BAR;
            PG8_LDB(B0, 1, 0); PG8_SCHED; PG8_LDA(At, 1, 0); PG8_STAGE(PG8_SA(0, 1), a2 + hstep, voffA);
            PG8_WAIT_L(8); PG8_BAR; PG8_WAIT_L(0); PG8_MMA(0, 0, At, B0); PG8_BAR; PG8_SCHED;
            PG8_LDB(B1, 1, 1); PG8_STAGE(PG8_SB(1, 0), b3, voffB);
            PG8_BAR; PG8_WAIT_L(0); PG8_MMA(0, 1, At, B1); PG8_BAR;
            PG8_LDA(At, 1, 1); PG8_STAGE(PG8_SA(1, 0), a3, voffA);
            PG8_BAR; PG8_WAIT_L(0); PG8_MMA(1, 0, At, B0); PG8_BAR; PG8_SCHED;
            PG8_STAGE(PG8_SB(1, 1), b3 + hstep, voffB);
            PG8_WAIT_V(6); PG8_BAR; PG8_MMA(1, 1, At, B1); PG8_BAR;
            }
        }
        if constexpr (ALIGN_EPI) { if (wr == 0) PG8_BAR; }
        if constexpr (!Epi::AFTER_DRAIN) { E(acc, cur, wr, wc, fr, fq); S.done(cur); }
        if (!has_next) break;
#pragma unroll
        for (int a = 0; a < 2; ++a)
#pragma unroll
            for (int b = 0; b < 2; ++b)
#pragma unroll
                for (int m = 0; m < 4; ++m)
#pragma unroll
                    for (int n = 0; n < 2; ++n) acc[a][b][m][n] = (f32x4){0.f, 0.f, 0.f, 0.f};
        cur = nxt; cA = nA; cB = nB; ++ui;
        if constexpr (ALIGN_EPI) { if (wr == 1) PG8_BAR; }
    }
    PG8_WAIT_V(0);
    if constexpr (!ALIGN_EPI) { if (wr == 0) PG8_BAR; }
    PG8_BAR;
    if constexpr (Epi::AFTER_DRAIN) { E.fused(acc, cur, wr, wc, fr, fq, lds, wid, lane); S.done(cur); }
#undef PG8_SA
#undef PG8_SB
#undef PG8_STAGE
#undef PG8_LDA
#undef PG8_LDB
#undef PG8_MMA
#undef PG8_WAIT_V
#undef PG8_WAIT_L
#undef PG8_BAR
#undef PG8_SCHED
}
}
namespace att {
using bf16 = __hip_bfloat16;
constexpr int   D = 128, NW = 8, QBLK = 32, KVBLK = 64;
constexpr float SCALE = 0.088388347648318440f;
constexpr float THR2 = 11.f;
constexpr float QSCALE = SCALE * 1.4426950408889634f;
constexpr int SDEPTH = 1;
constexpr int LDQ = 4608, LDK = 4608, LDO = 1024;
constexpr size_t SHM_V = KVBLK * D * 2, SHM_K = KVBLK * D * 2, SHM_ATTN = 2 * SHM_V + 2 * SHM_K + NW * 64 * 4;
using bf16x8 = __attribute__((ext_vector_type(8))) short;
using s16x4  = __attribute__((ext_vector_type(4))) short;
using f32x16 = __attribute__((ext_vector_type(16))) float;
using f32x8  = __attribute__((ext_vector_type(8))) float;
using u32x4  = __attribute__((ext_vector_type(4))) unsigned;
#define KSWZ(row, colB) ((row) * 256 + ((colB) ^ (((row) & 7) << 4)))
#define SBAR() __builtin_amdgcn_sched_barrier(0)
__device__ __forceinline__ int crow(int r, int hi) { return (r & 3) + 8 * (r >> 2) + 4 * hi; }
__device__ __forceinline__ unsigned cvtpk(float lo, float hi) {
  unsigned r; asm volatile("v_cvt_pk_bf16_f32 %0, %1, %2" : "=v"(r) : "v"(lo), "v"(hi)); return r;
}
template <typename TIn> struct Stage;
template <> struct Stage<bf16>  { using T = bf16x8;
  __device__ static __forceinline__ T ld8(const bf16* p) { return *reinterpret_cast<const bf16x8*>(p); }
  __device__ static __forceinline__ bf16x8 tobf(T x) { return x; } };
template <> struct Stage<float> { using T = f32x8;
  __device__ static __forceinline__ T ld8(const float* p) { return *reinterpret_cast<const f32x8*>(p); }
  __device__ static __forceinline__ bf16x8 tobf(T x) {
    u32x4 w = {cvtpk(x[0], x[1]), cvtpk(x[2], x[3]), cvtpk(x[4], x[5]), cvtpk(x[6], x[7])}; return *reinterpret_cast<bf16x8*>(&w); } };

__device__ __forceinline__ void partialSM(f32x16& p0) {
#pragma unroll
  for (int r = 0; r < 16; ++r) p0[r] = __builtin_amdgcn_exp2f(p0[r]);
}
__device__ __forceinline__ void finishSM(f32x16& p0, f32x16& p1, float& l_reg, bf16x8& pa0, bf16x8& pa1, bf16x8& pa2, bf16x8& pa3) {
  for (int r = 0; r < 16; ++r) p1[r] = __builtin_amdgcn_exp2f(p1[r]);
  float ps = 0; for (int r = 0; r < 16; ++r) ps += p0[r]; for (int r = 0; r < 16; ++r) ps += p1[r];
  { auto rr = __builtin_amdgcn_permlane32_swap(__float_as_uint(ps), __float_as_uint(ps), false, false);
    ps = __uint_as_float(rr[0]) + __uint_as_float(rr[1]); }
  l_reg += ps;
#define PK4(P, BASE, OUT) do { unsigned a0 = cvtpk(P[BASE + 0], P[BASE + 1]), a1 = cvtpk(P[BASE + 2], P[BASE + 3]);   \
    unsigned b0 = cvtpk(P[BASE + 4], P[BASE + 5]), b1 = cvtpk(P[BASE + 6], P[BASE + 7]);                              \
    auto r0 = __builtin_amdgcn_permlane32_swap(a0, b0, false, false); auto r1 = __builtin_amdgcn_permlane32_swap(a1, b1, false, false); \
    u32x4 w = {r0[0], r1[0], r0[1], r1[1]}; OUT = *reinterpret_cast<bf16x8*>(&w); } while (0)
  PK4(p0, 0, pa0); PK4(p0, 8, pa1); PK4(p1, 0, pa2); PK4(p1, 8, pa3);
#undef PK4
}
__device__ __forceinline__ void qkt(f32x16& p0, f32x16& p1, const bf16* Ks, const bf16x8* qr, const f32x16& negm, int r32, int hi) {
  const char* kb = (const char*)Ks + r32 * 32 + hi * 16;
#pragma unroll
  for (int d0 = 0; d0 < 8; ++d0) {
    bf16x8 b0 = *reinterpret_cast<const bf16x8*>(kb + d0 * 2048);
    bf16x8 b1 = *reinterpret_cast<const bf16x8*>(kb + d0 * 2048 + 1024);
    if (d0 == 0) { p0 = __builtin_amdgcn_mfma_f32_32x32x16_bf16(b0, qr[0], negm, 0, 0, 0); p1 = __builtin_amdgcn_mfma_f32_32x32x16_bf16(b1, qr[0], negm, 0, 0, 0); }
    else { p0 = __builtin_amdgcn_mfma_f32_32x32x16_bf16(b0, qr[d0], p0, 0, 0, 0); p1 = __builtin_amdgcn_mfma_f32_32x32x16_bf16(b1, qr[d0], p1, 0, 0, 0); } }
}
__device__ __forceinline__ int v_st(int k, int c) { const int kk = (k & ~0xC) | ((k & 4) << 1) | ((k & 8) >> 1); return ((kk >> 3) * 4 + (c >> 5)) * 512 + ((kk & 7) * 32 + (c & 31)) * 2; }
__device__ __forceinline__ int v_rd_base(int lane) { return ((lane & 3) << 3) | (((lane >> 2) & 3) << 6) | (((lane >> 4) & 1) << 5) | (((lane >> 5) & 1) << 8); }
constexpr int v_rd_off(int d0, int ks, int half) { return d0 * 512 + ks * 4096 + half * 2048; }
template <int OFF> __device__ __forceinline__ s16x4 tr_read(int vb) {
  s16x4 r; asm volatile("ds_read_b64_tr_b16 %0, %1 offset:%2" : "=&v"(r) : "v"(vb), "i"(OFF) : "memory"); return r;
}
template <int D0> __device__ __forceinline__ void pv_one(f32x16& od, int vb, bf16x8 pa0, bf16x8 pa1, bf16x8 pa2, bf16x8 pa3) {
  const s16x4 l0 = tr_read<v_rd_off(D0, 0, 0)>(vb), h0 = tr_read<v_rd_off(D0, 0, 1)>(vb), l1 = tr_read<v_rd_off(D0, 1, 0)>(vb), h1 = tr_read<v_rd_off(D0, 1, 1)>(vb);
  const s16x4 l2 = tr_read<v_rd_off(D0, 2, 0)>(vb), h2 = tr_read<v_rd_off(D0, 2, 1)>(vb), l3 = tr_read<v_rd_off(D0, 3, 0)>(vb), h3 = tr_read<v_rd_off(D0, 3, 1)>(vb);
  asm volatile("s_waitcnt lgkmcnt(0)" ::: "memory"); SBAR();
#define PK(L, H) (bf16x8){L[0], L[1], L[2], L[3], H[0], H[1], H[2], H[3]}
  od = __builtin_amdgcn_mfma_f32_32x32x16_bf16(pa0, PK(l0, h0), od, 0, 0, 0);
  od = __builtin_amdgcn_mfma_f32_32x32x16_bf16(pa1, PK(l1, h1), od, 0, 0, 0);
  od = __builtin_amdgcn_mfma_f32_32x32x16_bf16(pa2, PK(l2, h2), od, 0, 0, 0);
  od = __builtin_amdgcn_mfma_f32_32x32x16_bf16(pa3, PK(l3, h3), od, 0, 0, 0);
#undef PK
}
__device__ __forceinline__ void pv_d0(f32x16* o, int vb, bf16x8 pa0, bf16x8 pa1, bf16x8 pa2, bf16x8 pa3) {
  pv_one<0>(o[0], vb, pa0, pa1, pa2, pa3); pv_one<1>(o[1], vb, pa0, pa1, pa2, pa3); pv_one<2>(o[2], vb, pa0, pa1, pa2, pa3); pv_one<3>(o[3], vb, pa0, pa1, pa2, pa3);
}

template <typename TQ>
__device__ __forceinline__ void attn_dense_body(const TQ* __restrict__ Qb, const bf16* __restrict__ Kh, const bf16* __restrict__ Vh,
                                                float* __restrict__ Ob, int seq, char* lds, const float* __restrict__ qnw, const float* __restrict__ knw, const float* __restrict__ tab, int t0) {
  using SQ = Stage<TQ>;
  typedef __attribute__((address_space(3))) unsigned lds_u32;
  const int tid = threadIdx.x, lane = tid & 63, r32 = lane & 31, hi = lane >> 5;
  const int wid = __builtin_amdgcn_readfirstlane(tid >> 6);
  char* K_lds = lds; char* V_lds = lds + 4 * SHM_K;
  float* ws = (float*)(lds + 4 * SHM_V + 4 * SHM_K) + wid * 64; float* li_l = ws; float* al_l = ws + 32;
  float l_reg = 0; f32x16 o[4] = {}; bf16x8 qr[8]; f32x16 negm = {}; asm volatile("" : "+v"(negm));
  const TQ* Qw = Qb + (long)(wid * QBLK + r32) * LDQ + hi * 8;
  {
    const int t = t0 + wid * QBLK + r32; float x[8][8]; float ss = 0.f;
#pragma unroll
    for (int d0 = 0; d0 < 8; ++d0) { const u32x4 raw = *reinterpret_cast<const u32x4*>(Qw + d0 * 16);
#pragma unroll
      for (int k = 0; k < 4; ++k) { x[d0][2 * k] = __uint_as_float(raw[k] << 16); x[d0][2 * k + 1] = __uint_as_float(raw[k] & 0xffff0000u); ss += x[d0][2 * k] * x[d0][2 * k] + x[d0][2 * k + 1] * x[d0][2 * k + 1]; } }
    { auto rr = __builtin_amdgcn_permlane32_swap(__float_as_uint(ss), __float_as_uint(ss), false, false); ss = __uint_as_float(rr[0]) + __uint_as_float(rr[1]); }
    const float rstd = rsqrtf(ss * (1.f / 128.f) + 1e-6f); float n2 = 0.f;
#pragma unroll
    for (int d0 = 0; d0 < 8; ++d0) { const float* wp = qnw + d0 * 16 + hi * 8;
#pragma unroll
      for (int e = 0; e < 8; ++e) { x[d0][e] *= rstd * wp[e]; n2 += x[d0][e] * x[d0][e]; } }
    { auto rr = __builtin_amdgcn_permlane32_swap(__float_as_uint(n2), __float_as_uint(n2), false, false); n2 = __uint_as_float(rr[0]) + __uint_as_float(rr[1]); }
    float kwm = fmaxf(fabsf(knw[2 * lane]), fabsf(knw[2 * lane + 1]));
#pragma unroll
    for (int o_ = 1; o_ < 64; o_ <<= 1) kwm = fmaxf(kwm, __shfl_xor(kwm, o_));
    const float mref = fminf(sqrtf(n2) * QSCALE * 11.313708499f * kwm * 1.0005f, 60.f);
#pragma unroll
    for (int r = 0; r < 16; ++r) negm[r] = -mref;
    asm volatile("" : "+v"(negm));
#pragma unroll
    for (int half = 0; half < 2; ++half) { const int pos = half ? (t & 63) : (t >> 6);
#pragma unroll
      for (int b = 0; b < 2; ++b) { const float* tp = tab + (pos * 32 + b * 16 + hi * 8) * 2;
#pragma unroll
        for (int e = 0; e < 8; ++e) { const float c = tp[2 * e], sn = tp[2 * e + 1]; const float x1 = x[half * 4 + b][e], x2 = x[half * 4 + b + 2][e];
          x[half * 4 + b][e] = (x1 * c - x2 * sn) * QSCALE; x[half * 4 + b + 2][e] = (x2 * c + x1 * sn) * QSCALE; } } }
#pragma unroll
    for (int d0 = 0; d0 < 8; ++d0) { u32x4 w = {cvtpk(x[d0][0], x[d0][1]), cvtpk(x[d0][2], x[d0][3]), cvtpk(x[d0][4], x[d0][5]), cvtpk(x[d0][6], x[d0][7])}; qr[d0] = *reinterpret_cast<bf16x8*>(&w); }
  }
  const int vb0 = (int)(uintptr_t)V_lds + v_rd_base(lane);
  unsigned koff, voff;
  { const int d0 = wid >> 1, row = (wid & 1) * 32 + (lane >> 1), h_ = lane & 1; koff = (unsigned)(row * LDK + d0 * 16 + h_ * 8) * 2u; }
  { const int sub = wid * 2 + (lane >> 5), kk = (sub >> 2) * 8 + ((lane & 31) >> 2), c = (sub & 3) * 32 + (lane & 3) * 8;
    const int k = (kk & ~0xC) | ((kk & 4) << 1) | ((kk & 8) >> 1); voff = (unsigned)(k * LDK + c) * 2u; }
  const __attribute__((address_space(3))) char* kdst = (const __attribute__((address_space(3))) char*)(unsigned)(uintptr_t)(K_lds + wid * 1024);
  const __attribute__((address_space(3))) char* vdst = (const __attribute__((address_space(3))) char*)(unsigned)(uintptr_t)(V_lds + wid * 1024);
#define DMA(k0, off) do { const char* kt_ = (const char*)Kh + (size_t)(k0) * (LDK * 2); const char* vt_ = (const char*)Vh + (size_t)(k0) * (LDK * 2); \
      __builtin_amdgcn_global_load_lds((const unsigned*)(kt_ + koff), (lds_u32*)(kdst + (off)), 16, 0, 0); \
      __builtin_amdgcn_global_load_lds((const unsigned*)(kt_ + 128 + koff), (lds_u32*)(kdst + (off) + 8192), 16, 0, 0); \
      __builtin_amdgcn_global_load_lds((const unsigned*)(vt_ + voff), (lds_u32*)(vdst + (off)), 16, 0, 0); \
      __builtin_amdgcn_global_load_lds((const unsigned*)(vt_ + 32 * LDK * 2 + voff), (lds_u32*)(vdst + (off) + 8192), 16, 0, 0); } while (0)
#define VWAIT() asm volatile("s_waitcnt vmcnt(0)" ::: "memory")
#define ROT() do { const int t_ = sl_prev; sl_prev = sl_cur; sl_cur = sl_n1; sl_n1 = sl_n2; sl_n2 = t_; } while (0)
#define WAITBAR(N) asm volatile("s_waitcnt vmcnt(" #N ") lgkmcnt(0)\n\ts_barrier" ::: "memory")
  f32x16 pA0, pA1, pB0, pB1; bf16x8 pa0, pa1, pa2, pa3; const int NT = seq / KVBLK;
  DMA(0, 0); DMA(KVBLK, (int)SHM_K); DMA(2 * KVBLK, 2 * (int)SHM_K); WAITBAR(4);
  qkt(pA0, pA1, (const bf16*)K_lds, qr, negm, r32, hi); partialSM(pA0);
  int sl_prev = 0, sl_cur = (int)SHM_K, sl_n1 = 2 * (int)SHM_K, sl_n2 = 3 * (int)SHM_K;
#define STEP(PC0, PC1, PP0, PP1, LD, jn2) do { \
    if (LD) { DMA((jn2) * KVBLK, sl_n2); } SBAR(); \
    qkt(PC0, PC1, (const bf16*)(K_lds + sl_cur), qr, negm, r32, hi); \
    finishSM(PP0, PP1, l_reg, pa0, pa1, pa2, pa3); SBAR(); \
    pv_d0(o, vb0 + sl_prev, pa0, pa1, pa2, pa3); partialSM(PC0); \
    if (LD) { WAITBAR(4); } else { WAITBAR(0); } ROT(); } while (0)
  int j = 1;
  for (; j + 4 < NT; j += 2) {
    STEP(pB0, pB1, pA0, pA1, true, j + 2);
    STEP(pA0, pA1, pB0, pB1, true, j + 3);
  }
  STEP(pB0, pB1, pA0, pA1, true, j + 2);
  STEP(pA0, pA1, pB0, pB1, false, 0);
  STEP(pB0, pB1, pA0, pA1, false, 0);
  finishSM(pB0, pB1, l_reg, pa0, pa1, pa2, pa3); SBAR();
  pv_d0(o, vb0 + sl_prev, pa0, pa1, pa2, pa3);
  if (hi == 0) li_l[r32] = l_reg; asm volatile("s_waitcnt lgkmcnt(0)" ::: "memory");
  float rli[16];
#pragma unroll
  for (int r = 0; r < 16; ++r) rli[r] = __builtin_amdgcn_rcpf(li_l[crow(r, hi)]);
  float* Ow = Ob + (long)(wid * QBLK) * LDO;
#pragma unroll
  for (int r = 0; r < 16; ++r) { int orow = crow(r, hi);
    for (int d0 = 0; d0 < 4; ++d0) __builtin_nontemporal_store(o[d0][r] * rli[r], Ow + (long)orow * LDO + d0 * 32 + r32); }
#undef DMA
#undef VWAIT
#undef ROT
#undef WAITBAR
#undef STEP
}
#undef KSWZ
#undef SBAR
}
constexpr int M = 16384, DM = 2048, NIN = 4608, AW = 1024, LW = 1024, MIXW = 2048;
constexpr int C_Q = 0, C_K = 1024, C_V = 1280, C_GA = 1536, C_XR = 2560, C_GL = 3584;
constexpr float EPS = 1e-6f;
constexpr int NTHREADS = 512, NWAVES = 8;
constexpr int LDS_BYTES = 135168;
constexpr size_t MiB = 1u << 20;
constexpr size_t WS_WIN = 2 * MiB;
constexpr size_t WS_WOUT = 20 * MiB;
constexpr size_t WS_WG = 28 * MiB;
constexpr size_t WS_TAB = 29 * MiB;
constexpr size_t WS_CARRY = 31 * MiB;
constexpr size_t WS_SUMM = 30 * MiB;
constexpr size_t WS_XN = 32 * MiB;
constexpr size_t WS_PROJ = 96 * MiB;
constexpr size_t WS_O = 240 * MiB;
constexpr size_t WS_HF = 304 * MiB;
constexpr size_t WS_HB = 368 * MiB;
constexpr size_t WS_END = 432 * MiB;

#define LAS __attribute__((address_space(3)))
typedef unsigned short bf16r;
typedef float f32x4 __attribute__((ext_vector_type(4)));
typedef float f32x2 __attribute__((ext_vector_type(2)));
typedef float f32x16 __attribute__((ext_vector_type(16)));
typedef unsigned u32x4 __attribute__((ext_vector_type(4)));
typedef unsigned u32x2 __attribute__((ext_vector_type(2)));
typedef short bf16x8 __attribute__((ext_vector_type(8)));

__device__ __forceinline__ unsigned pk2(float lo, float hi) { unsigned r; asm volatile("v_cvt_pk_bf16_f32 %0, %1, %2" : "=v"(r) : "v"(lo), "v"(hi)); return r; }
__device__ __forceinline__ float bflo(unsigned v) { return __uint_as_float(v << 16); }
__device__ __forceinline__ float bfhi(unsigned v) { return __uint_as_float(v & 0xffff0000u); }
__device__ __forceinline__ float wave_sum(float v) {
#pragma unroll
    for (int o = 1; o < 64; o <<= 1) v += __shfl_xor(v, o);
    return v;
}
__device__ __forceinline__ float sigmoidf_(float z) { return __builtin_amdgcn_rcpf(1.f + __expf(-z)); }

struct Args { const float* in[15]; float* out; unsigned char* ws; int ph_lo, ph_hi; };
enum { I_X = 0, I_NORMW, I_WIN, I_QNW, I_KNW, I_CONVW, I_CONVB, I_WA, I_BA, I_WX, I_BX, I_LAM, I_ANW, I_LNW, I_WOUT };

__device__ __forceinline__ void transpose_item(const float* W, int ldw, int nblk, bf16r* WT, int ldo, LAS float* scr, int item, int lane) {
    const int kb = item / nblk, nb = item % nblk, k0 = 64 * kb, n0 = 32 * nb;
#pragma unroll 8
    for (int i = 0; i < 32; ++i) { const int kk = 2 * i + (lane >> 5); scr[kk * 33 + (lane & 31)] = __builtin_nontemporal_load(W + (size_t)(k0 + kk) * ldw + n0 + (lane & 31)); }
    asm volatile("s_waitcnt lgkmcnt(0)" ::: "memory");
    const int c = lane & 7;
#pragma unroll
    for (int j = 0; j < 4; ++j) { const int n = (lane >> 3) + 8 * j; const LAS float* s = scr + (8 * c) * 33 + n;
        u32x4 o; o.x = pk2(s[0 * 33], s[1 * 33]); o.y = pk2(s[2 * 33], s[3 * 33]); o.z = pk2(s[4 * 33], s[5 * 33]); o.w = pk2(s[6 * 33], s[7 * 33]);
        *(u32x4*)(WT + (size_t)(n0 + n) * ldo + k0 + 8 * c) = o; }
    asm volatile("s_waitcnt lgkmcnt(0)" ::: "memory");
}
__device__ __forceinline__ void p0_prologue(const Args& a, LAS unsigned char* lds, int gw, int NGW, int lane, int wave) {
    unsigned char* ws = a.ws;
    LAS float* scr = (LAS float*)(lds + wave * 16384);
    constexpr int I_IN = (DM / 64) * (NIN / 32), I_OUT = (MIXW / 64) * (DM / 32), I_G = 32 * 8;
    for (int it = gw; it < I_IN + I_OUT + I_G; it += NGW) {
        if (it < I_IN) transpose_item(a.in[I_WIN], NIN, NIN / 32, (bf16r*)(ws + WS_WIN), DM, scr, it, lane);
        else if (it < I_IN + I_OUT) transpose_item(a.in[I_WOUT], DM, DM / 32, (bf16r*)(ws + WS_WOUT), MIXW, scr, it - I_IN, lane);
        else { const int r = it - I_IN - I_OUT, mat = r >> 3, sub = r & 7, which = mat >> 4, db = mat & 15;
            const float* src = (which ? a.in[I_WX] : a.in[I_WA]) + (size_t)db * 128 * 128;
            bf16r* dst = (bf16r*)(ws + WS_WG) + (size_t)db * 256 * 128 + (size_t)which * 128 * 128;
            transpose_item(src, 128, 4, dst, 128, scr, sub, lane); }
    }
    { const int e = gw * 64 + lane;
      if (e < 256 * 32) { const int pos = e >> 5, i = e & 31;
        const float invf = __builtin_amdgcn_exp2f(-(float)i * 0.41524101186092029f);
        const float ang = (float)pos * invf;
        const double ad = (double)ang; const double k = __builtin_rint(ad * 0.63661977236758134);
        const double r = __builtin_fma(-k, 1.5707963267948966, ad); const double r2 = r * r;
        const double sn = r * (1.0 + r2 * (-1.0 / 6 + r2 * (1.0 / 120 + r2 * (-1.0 / 5040 + r2 * (1.0 / 362880 + r2 * (-1.0 / 39916800))))));
        const double cs = 1.0 + r2 * (-0.5 + r2 * (1.0 / 24 + r2 * (-1.0 / 720 + r2 * (1.0 / 40320 + r2 * (-1.0 / 3628800 + r2 * (1.0 / 479001600))))));
        const int q = ((int)k) & 3;
        const double c_ = (q == 0) ? cs : (q == 1) ? -sn : (q == 2) ? -cs : sn;
        const double s_ = (q == 0) ? sn : (q == 1) ? cs : (q == 2) ? -sn : -cs;
        f32x2 o; o.x = (float)c_; o.y = (float)s_; ((f32x2*)(ws + WS_TAB))[e] = o; } }
    const float* x = a.in[I_X]; const f32x4* nw = (const f32x4*)a.in[I_NORMW] + lane;
    for (int m = gw; m < M; m += NGW) {
        const f32x4* xr = (const f32x4*)(x + (size_t)m * DM) + lane; f32x4 v[8]; float s = 0.f;
#pragma unroll
        for (int j = 0; j < 8; ++j) { v[j] = __builtin_nontemporal_load(xr + 64 * j); s += (v[j].x * v[j].x + v[j].y * v[j].y) + (v[j].z * v[j].z + v[j].w * v[j].w); }
        const float rstd = rsqrtf(wave_sum(s) * (1.f / DM) + EPS);
        u32x2* o8 = (u32x2*)((bf16r*)(ws + WS_XN) + (size_t)m * DM) + lane;
#pragma unroll
        for (int j = 0; j < 8; ++j) { const f32x4 w = nw[64 * j]; u32x2 o; o.x = pk2(v[j].x * rstd * w.x, v[j].y * rstd * w.y); o.y = pk2(v[j].z * rstd * w.z, v[j].w * rstd * w.w); o8[64 * j] = o; }
    }
}

__device__ __forceinline__ void p2_qkprep(const Args& a, int gw, int NGW, int lane) {
    bf16r* proj = (bf16r*)(a.ws + WS_PROJ); const float* tab = (const float*)(a.ws + WS_TAB);
    const f32x2 kw = ((const f32x2*)a.in[I_KNW])[lane];
    const int i0 = (2 * lane) & 31; const float sgn = (lane & 16) ? 1.f : -1.f;
    for (int t0 = gw; t0 < M; t0 += 4 * NGW) {
        unsigned v[4][2]; f32x4 cs[4]; unsigned* rowp[4];
#pragma unroll
        for (int q = 0; q < 4; ++q) { const int t = min(t0 + q * NGW, M - 1); const int pos = (lane < 32) ? (t >> 6) : (t & 63);
            cs[q] = *(const f32x4*)(tab + (pos * 32 + i0) * 2);
            rowp[q] = (unsigned*)(proj + (size_t)t * NIN + C_K) + lane; v[q][0] = rowp[q][0]; v[q][1] = rowp[q][64]; }
#pragma unroll
        for (int q = 0; q < 4; ++q) { if (t0 + q * NGW >= M) break;
#pragma unroll
            for (int hh = 0; hh < 2; ++hh) {
                const float x0 = bflo(v[q][hh]), x1 = bfhi(v[q][hh]);
                const float rstd = rsqrtf(wave_sum(x0 * x0 + x1 * x1) * (1.f / 128.f) + EPS);
                const float y0 = x0 * rstd * kw.x, y1 = x1 * rstd * kw.y;
                const float p0 = __shfl_xor(y0, 16), p1 = __shfl_xor(y1, 16);
                rowp[q][hh * 64] = pk2(y0 * cs[q].x + sgn * p0 * cs[q].y, y1 * cs[q].z + sgn * p1 * cs[q].w); } }
    }
}

constexpr int L_SUM = 0, L_CW = 8192, L_WT = 16384;
#define KSWZ_(row, colB) ((row) * 256 + ((colB) ^ (((row) & 7) << 4)))
__device__ __forceinline__ int crow_(int r, int hi) { return (r & 3) + 8 * (r >> 2) + 4 * hi; }
template <int DIR>
__device__ __forceinline__ void lru_unit(const Args& a, LAS unsigned char* lds, int ck, int blk, bool load_w) {
    int tid = threadIdx.x; asm volatile("" : "+v"(tid));
    const int lane = tid & 63, r32 = lane & 31, hi = lane >> 5;
    const int w = __builtin_amdgcn_readfirstlane(tid >> 6);
    constexpr int d = DIR;
    unsigned char* ws = a.ws;
    const bf16r* proj = (const bf16r*)(ws + WS_PROJ);
    LAS float* CWl = (LAS float*)(lds + L_CW);
    LAS f32x2* SUM = (LAS f32x2*)(lds + L_SUM);
    __syncthreads();
    if (load_w) {
        const bf16r* Wt = (const bf16r*)(ws + WS_WG) + (size_t)(d * 8 + blk) * 256 * 128;
#pragma unroll
        for (int i = 0; i < 8; ++i) { const int p = tid + 512 * i, row = p >> 4, c16 = p & 15;
            const u32x4 v = *(const u32x4*)(Wt + row * 128 + c16 * 8); *(LAS u32x4*)(lds + L_WT + KSWZ_(row, c16 * 16)) = v; }
        const float* cw = a.in[I_CONVW]; const float* cbias = a.in[I_CONVB];
        for (int e = tid; e < 640; e += 512) CWl[e] = e < 512 ? cw[(e >> 7) * 1024 + blk * 128 + (e & 127)] : cbias[blk * 128 + (e - 512)];
    }
    __syncthreads();
    const int t = ck * 256 + w * 32 + r32;
    bf16x8 A[8];
#pragma unroll
    for (int kk = 0; kk < 8; ++kk) { const int c0 = kk * 16 + hi * 8;
        f32x4 acc0 = *(const LAS f32x4*)(CWl + 512 + c0), acc1 = *(const LAS f32x4*)(CWl + 512 + c0 + 4);
#pragma unroll
        for (int j = 0; j < 4; ++j) { const int tt = t + j - 2; const bool ok = tt >= 0 && tt < M; const int tc = ok ? tt : t;
            u32x4 xv = *(const u32x4*)(proj + (size_t)tc * NIN + C_XR + blk * 128 + c0);
            if (!ok) xv = (u32x4){0u, 0u, 0u, 0u};
            const f32x4 w0 = *(const LAS f32x4*)(CWl + j * 128 + c0), w1 = *(const LAS f32x4*)(CWl + j * 128 + c0 + 4);
            acc0.x += w0.x * bflo(xv.x); acc0.y += w0.y * bfhi(xv.x); acc0.z += w0.z * bflo(xv.y); acc0.w += w0.w * bfhi(xv.y);
            acc1.x += w1.x * bflo(xv.z); acc1.y += w1.y * bfhi(xv.z); acc1.z += w1.z * bflo(xv.w); acc1.w += w1.w * bfhi(xv.w); }
        u32x4 o; o.x = pk2(acc0.x, acc0.y); o.y = pk2(acc0.z, acc0.w); o.z = pk2(acc1.x, acc1.y); o.w = pk2(acc1.z, acc1.w);
        A[kk] = __builtin_bit_cast(bf16x8, o); if ((kk & 3) == 3) asm volatile("" ::: "memory"); }
    bf16x8 Bid[2];
#pragma unroll
    for (int kq = 0; kq < 2; ++kq)
#pragma unroll
        for (int j = 0; j < 8; ++j) Bid[kq][j] = (16 * kq + 8 * hi + j == r32) ? (short)0x3F80 : (short)0;
    unsigned* hcout = (unsigned*)(ws + (d ? WS_HB : WS_HF));
#pragma unroll
    for (int rd = 0; rd < 4; ++rd) {
        float hl[1][16], cq[1][16];
#pragma unroll
        for (int cc = 0; cc < 1; ++cc) { const int ct = rd + cc;
            f32x16 accr = {}, acci = {}, accx = {};
#pragma unroll
            for (int kk = 0; kk < 8; ++kk) {
                const bf16x8 br = *(const LAS bf16x8*)(lds + L_WT + KSWZ_(ct * 32 + r32, (kk * 16 + hi * 8) * 2));
                const bf16x8 bi = *(const LAS bf16x8*)(lds + L_WT + KSWZ_(128 + ct * 32 + r32, (kk * 16 + hi * 8) * 2));
                accr = __builtin_amdgcn_mfma_f32_32x32x16_bf16(A[kk], br, accr, 0, 0, 0);
                acci = __builtin_amdgcn_mfma_f32_32x32x16_bf16(A[kk], bi, acci, 0, 0, 0);
            }
            accx = __builtin_amdgcn_mfma_f32_32x32x16_bf16(A[2 * ct], Bid[0], accx, 0, 0, 0);
            accx = __builtin_amdgcn_mfma_f32_32x32x16_bf16(A[2 * ct + 1], Bid[1], accx, 0, 0, 0);
            const int cidx = d * 1024 + blk * 128 + ct * 32 + r32;
            const float ba = a.in[I_BA][cidx], bx = a.in[I_BX][cidx], lam = a.in[I_LAM][cidx];
            const float sp8 = 8.f * log1pf(__expf(-lam));
            float av[16], bv[16];
#pragma unroll
            for (int r = 0; r < 16; ++r) {
                const float rg = __builtin_amdgcn_rcpf(1.f + __builtin_amdgcn_exp2f(-1.4426950408889634f * (accr[r] + ba)));
                const float ig = __builtin_amdgcn_rcpf(1.f + __builtin_amdgcn_exp2f(-1.4426950408889634f * (acci[r] + bx)));
                const float la = -sp8 * rg; const float aa = __builtin_amdgcn_exp2f(1.4426950408889634f * la);
                const float om = __builtin_fmaf(-aa, aa, 1.f);
                av[r] = aa; bv[r] = __builtin_amdgcn_sqrtf(om) * ig * accx[r];
            }
            float Pg[4], Hg[4];
#pragma unroll
            for (int g = 0; g < 4; ++g) { float h = 0.f, cp = 1.f;
#pragma unroll
                for (int e = 0; e < 4; ++e) { const int r = 4 * g + (DIR == 0 ? e : 3 - e); h = av[r] * h + bv[r]; cp *= av[r]; bv[r] = h; av[r] = cp; }
                Pg[g] = cp; Hg[g] = h; }
            float F = 1.f, E = 0.f, Fg[4], Eg[4];
#pragma unroll
            for (int gi = 0; gi < 4; ++gi) { const int g = DIR == 0 ? gi : 3 - gi;
                const float pP = __shfl_xor(Pg[g], 32), pH = __shfl_xor(Hg[g], 32);
                const float Pe = hi ? pP : Pg[g], He = hi ? pH : Hg[g];
                const float Po = hi ? Pg[g] : pP, Ho = hi ? Hg[g] : pH;
                if (DIR == 0) { const float F1 = Pe * F, E1 = Pe * E + He; Fg[g] = hi ? F1 : F; Eg[g] = hi ? E1 : E; F = Po * F1; E = Po * E1 + Ho; }
                else          { const float F1 = Po * F, E1 = Po * E + Ho; Fg[g] = hi ? F : F1; Eg[g] = hi ? E : E1; F = Pe * F1; E = Pe * E1 + He; } }
            if (hi == 0) { f32x2 o; o.x = F; o.y = E; SUM[(rd * 8 + w) * 32 + r32] = o; }
#pragma unroll
            for (int r = 0; r < 16; ++r) { hl[cc][r] = bv[r] + av[r] * Eg[r >> 2]; cq[cc][r] = av[r] * Fg[r >> 2]; }
        }
        __syncthreads();
        {
            const int ct = rd; float Fw = 1.f, Ew = 0.f;
            if (DIR == 0) { for (int wp = 0; wp < w; ++wp) { const f32x2 fe = SUM[(rd * 8 + wp) * 32 + r32]; Ew = fe.x * Ew + fe.y; Fw *= fe.x; } }
            else          { for (int wp = 7; wp > w; --wp) { const f32x2 fe = SUM[(rd * 8 + wp) * 32 + r32]; Ew = fe.x * Ew + fe.y; Fw *= fe.x; } }
            const size_t o0 = (size_t)(ck * 256 + w * 32) * LW + blk * 128 + ct * 32 + r32;
#pragma unroll
            for (int r = 0; r < 16; ++r) { const size_t oo = o0 + (size_t)crow_(r, hi) * LW;
                __builtin_nontemporal_store(pk2(hl[0][r] + cq[0][r] * Ew, cq[0][r] * Fw), hcout + oo); }
        }
        if (tid < 32) {
            float F = 1.f, E = 0.f;
#pragma unroll
            for (int wi = 0; wi < 8; ++wi) { const int wp = DIR == 0 ? wi : 7 - wi; const f32x2 fe = SUM[(rd * 8 + wp) * 32 + tid]; E = fe.x * E + fe.y; F *= fe.x; }
            f32x2 o; o.x = F; o.y = E; ((f32x2*)(ws + WS_SUMM))[(ck * 2 + d) * 1024 + blk * 128 + rd * 32 + tid] = o;
        }
    }
}
__device__ __forceinline__ void lru_phase(const Args& a, LAS unsigned char* lds, int bid, int G, int nrep) {
    const int key = bid & 15, d = key & 1, blk = key >> 1, ck0 = bid >> 4, dck = G >> 4;
    if (d == 0) { bool first = true; for (int c_ = ck0; c_ < 64 * nrep; c_ += dck) { lru_unit<0>(a, lds, c_ & 63, blk, first); first = false; } }
    else        { bool first = true; for (int c_ = ck0; c_ < 64 * nrep; c_ += dck) { lru_unit<1>(a, lds, c_ & 63, blk, first); first = false; } }
    __syncthreads();
}
__device__ __forceinline__ void carry_phase(const Args& a, int gw, int NGW, int lane) {
    const f32x2* summ = (const f32x2*)(a.ws + WS_SUMM); float* carry = (float*)(a.ws + WS_CARRY);
    for (int ch = gw; ch < 2048; ch += NGW) { const int d = ch >> 10, c = ch & 1023, kk = d ? 63 - lane : lane;
        const f32x2 s = summ[(kk * 2 + d) * 1024 + c]; float P = s.x, H = s.y;
#pragma unroll
        for (int off = 1; off < 64; off <<= 1) { const float Pp = __shfl_up(P, off), Hp = __shfl_up(H, off); if (lane >= off) { H = P * Hp + H; P = P * Pp; } }
        const float cin = __shfl_up(H, 1);
        carry[(kk * 2 + d) * 1024 + c] = lane ? cin : 0.f; }
}

__device__ __forceinline__ void p4_mix(const Args& a, int gw, int NGW, int lane) {
    unsigned char* ws = a.ws;
    const bf16r* proj = (const bf16r*)(ws + WS_PROJ); bf16r* mixed = (bf16r*)(ws + WS_XN);
    const float* O = (const float*)(ws + WS_O);
    const unsigned* HCF = (const unsigned*)(ws + WS_HF); const unsigned* HCB = (const unsigned*)(ws + WS_HB);
    const float* carry = (const float*)(ws + WS_CARRY);
    const f32x4* anw = (const f32x4*)a.in[I_ANW] + lane; const f32x4* lnw = (const f32x4*)a.in[I_LNW] + lane;
    for (int b8 = gw; b8 < M / 8; b8 += NGW) {
        const int ck = b8 >> 5; f32x4 cf[4], cb[4];
#pragma unroll
        for (int j = 0; j < 4; ++j) { cf[j] = ((const f32x4*)(carry + (ck * 2 + 0) * 1024) + lane)[64 * j]; cb[j] = ((const f32x4*)(carry + (ck * 2 + 1) * 1024) + lane)[64 * j]; }
        for (int rr = 0; rr < 8; ++rr) { const int m = b8 * 8 + rr;
        f32x4 v[4], u[4]; float s1 = 0.f, s2 = 0.f;
#pragma unroll
        for (int j = 0; j < 4; ++j) {
            v[j] = __builtin_nontemporal_load((const f32x4*)(O + (size_t)m * AW) + lane + 64 * j);
            const u32x4 f = __builtin_nontemporal_load((const u32x4*)(HCF + (size_t)m * LW) + lane + 64 * j), b = __builtin_nontemporal_load((const u32x4*)(HCB + (size_t)m * LW) + lane + 64 * j);
            u[j].x = (bflo(f.x) + bfhi(f.x) * cf[j].x) + (bflo(b.x) + bfhi(b.x) * cb[j].x);
            u[j].y = (bflo(f.y) + bfhi(f.y) * cf[j].y) + (bflo(b.y) + bfhi(b.y) * cb[j].y);
            u[j].z = (bflo(f.z) + bfhi(f.z) * cf[j].z) + (bflo(b.z) + bfhi(b.z) * cb[j].z);
            u[j].w = (bflo(f.w) + bfhi(f.w) * cf[j].w) + (bflo(b.w) + bfhi(b.w) * cb[j].w);
            s1 += (v[j].x * v[j].x + v[j].y * v[j].y) + (v[j].z * v[j].z + v[j].w * v[j].w);
            s2 += (u[j].x * u[j].x + u[j].y * u[j].y) + (u[j].z * u[j].z + u[j].w * u[j].w); }
        const float r1 = rsqrtf(wave_sum(s1) * (1.f / AW) + EPS), r2 = rsqrtf(wave_sum(s2) * (1.f / LW) + EPS);
        const u32x2* ga = (const u32x2*)(proj + (size_t)m * NIN + C_GA) + lane; const u32x2* gl = (const u32x2*)(proj + (size_t)m * NIN + C_GL) + lane;
        u32x2* mo = (u32x2*)(mixed + (size_t)m * MIXW) + lane;
#pragma unroll
        for (int j = 0; j < 4; ++j) {
            { const u32x2 g = __builtin_nontemporal_load(ga + 64 * j); const f32x4 w = anw[64 * j];
              const float g0 = bflo(g.x), g1 = bfhi(g.x), g2 = bflo(g.y), g3 = bfhi(g.y);
              u32x2 o; o.x = pk2(v[j].x * r1 * w.x * g0 * sigmoidf_(g0), v[j].y * r1 * w.y * g1 * sigmoidf_(g1));
              o.y = pk2(v[j].z * r1 * w.z * g2 * sigmoidf_(g2), v[j].w * r1 * w.w * g3 * sigmoidf_(g3)); mo[64 * j] = o; }
            { const u32x2 g = __builtin_nontemporal_load(gl + 64 * j); const f32x4 w = lnw[64 * j];
              const float g0 = bflo(g.x), g1 = bfhi(g.x), g2 = bflo(g.y), g3 = bfhi(g.y);
              u32x2 o; o.x = pk2(u[j].x * r2 * w.x * g0 * sigmoidf_(g0), u[j].y * r2 * w.y * g1 * sigmoidf_(g1));
              o.y = pk2(u[j].z * r2 * w.z * g2 * sigmoidf_(g2), u[j].w * r2 * w.w * g3 * sigmoidf_(g3)); mo[256 + 64 * j] = o; }
        }
        }
    }
}

#define RLX_AGENT __ATOMIC_RELAXED, __HIP_MEMORY_SCOPE_AGENT
#define XB_TMO      128
#define XB_XCNT(j)  (256  + 64 * (j))
#define XB_XSUB(j)  (1280 + 64 * (j))
#define XB_XGEN(j)  (2304 + 64 * (j))
#define XB_TOP      3328
#define XB_TOPGEN   3392
#define XCD_BAR_WORDS 3456
#define XB_SPIN_CAP (1u << 18)

__device__ __forceinline__ unsigned xb_ld(unsigned* p)              { return __hip_atomic_load(p, __ATOMIC_RELAXED, __HIP_MEMORY_SCOPE_AGENT); }
__device__ __forceinline__ unsigned xb_add(unsigned* p, unsigned v) { return __hip_atomic_fetch_add(p, v, __ATOMIC_RELAXED, __HIP_MEMORY_SCOPE_AGENT); }
__device__ __forceinline__ unsigned xb_xcc_id() { return (unsigned)__builtin_amdgcn_s_getreg((3 << 11) | 20) & 0xFu; }
#define XB_SPIN(cond, bar) do { unsigned _sp = 0; while (cond) { __builtin_amdgcn_s_sleep(1); \
    if ((++_sp & 255u) == 0u) { if (xb_ld(&(bar)[XB_TMO])) break; if (_sp > XB_SPIN_CAP) { atomicAdd(&(bar)[XB_TMO], 1u); break; } } } } while (0)

struct XcdBarrier {
    unsigned* bar; unsigned x;
    volatile LAS unsigned* st;
};

__device__ __forceinline__ XcdBarrier xcd_barrier_post(unsigned* bar, volatile LAS unsigned* st) {
    XcdBarrier b; b.bar = bar; b.x = xb_xcc_id(); b.st = st;
    if (threadIdx.x == 0) (void)xb_add(&bar[XB_XCNT(b.x)], 1u);
    return b;
}
__device__ __forceinline__ void xcd_barrier_complete(unsigned* bar, unsigned x, unsigned& nloc, unsigned& nx) {
    const unsigned G = gridDim.x * gridDim.y * gridDim.z;
    unsigned sum, cnt, mine, sp = 0u;
    for (;;) {
        sum = 0u; cnt = 0u; mine = 0u;
#pragma unroll
        for (unsigned j = 0; j < 16; ++j) { const unsigned c = xb_ld(&bar[XB_XCNT(j)]); sum += c; cnt += (c > 0u) ? 1u : 0u; mine = (j == x) ? c : mine; }
        if (sum == G) break;
        __builtin_amdgcn_s_sleep(1);
        if ((++sp & 255u) == 0u) { if (xb_ld(&bar[XB_TMO])) break; if (sp > XB_SPIN_CAP) { atomicAdd(&bar[XB_TMO], 1u); break; } }
    }
    nloc = mine > 0u ? mine : 1u; nx = cnt > 0u ? cnt : 1u;
}

__device__ __forceinline__ void xcd_barrier(const XcdBarrier& b) {
    asm volatile("s_waitcnt vmcnt(0)" ::: "memory");
    __syncthreads();
    if (threadIdx.x == 0) {
        unsigned* bar = b.bar;
        __builtin_amdgcn_s_waitcnt(0);
        unsigned nloc = b.st[0], nx = b.st[1];
        if (nloc == 0u) { xcd_barrier_complete(bar, b.x, nloc, nx); b.st[0] = nloc; b.st[1] = nx; }
        const unsigned old = xb_add(&bar[XB_XSUB(b.x)], 1u);
        const unsigned gen = old / nloc;
        if (old + 1u == (gen + 1u) * nloc) {
            __builtin_amdgcn_fence(__ATOMIC_RELEASE, "agent");
            asm volatile("s_waitcnt vmcnt(0)" ::: "memory");
            const unsigned og = xb_add(&bar[XB_TOP], 1u);
            const unsigned tg = og / nx;
            if (og + 1u == (tg + 1u) * nx) xb_add(&bar[XB_TOPGEN], 1u);
            else XB_SPIN(xb_ld(&bar[XB_TOPGEN]) == tg, bar);
            __builtin_amdgcn_fence(__ATOMIC_ACQUIRE, "agent");
            xb_add(&bar[XB_XGEN(b.x)], 1u);
            asm volatile("s_waitcnt vmcnt(0)" ::: "memory");
        } else {
            XB_SPIN(xb_ld(&bar[XB_XGEN(b.x)]) == gen, bar);
            __builtin_amdgcn_fence(__ATOMIC_ACQUIRE, "agent");
            asm volatile("s_waitcnt vmcnt(0)" ::: "memory");
        }
    }
    __syncthreads();
}

__global__ void __launch_bounds__(NTHREADS) hybrid_fwd(Args args) {
    extern __shared__ __attribute__((aligned(16))) unsigned char lds_raw[];
    LAS unsigned char* lds = (LAS unsigned char*)lds_raw;
    __shared__ __attribute__((aligned(16))) unsigned xb_st[4];
    cg::grid_group grid = cg::this_grid();
    const int tid = threadIdx.x, lane = tid & 63, wave = __builtin_amdgcn_readfirstlane(tid >> 6);
    if (tid < 4) xb_st[tid] = 0u;
    __syncthreads();
    const XcdBarrier xbar = xcd_barrier_post((unsigned*)args.ws, (volatile LAS unsigned*)xb_st);
    const int G = gridDim.x, bid = blockIdx.x;
    const int gw = bid * NWAVES + wave, NGW = G * NWAVES;
    unsigned char* ws = args.ws;
    const int lo = args.ph_lo, hi = args.ph_hi;
#define IN(k) (lo <= (k) && (k) < hi)
#ifndef REP
#define REP -1
#endif
#define NREP(k) ((REP) == (k) ? 2 : 1)
#define SEAM(k) do { if (IN(k) && IN((k) + 1)) xcd_barrier(xbar); } while (0)
    if (lo > hi) grid.sync();

    if (IN(0)) { p0_prologue(args, lds, gw, NGW, lane, wave); __syncthreads(); }
    SEAM(0);
    if (IN(1)) {
        pg8::Gemm g{(const pg8::bf16_t*)(ws + WS_XN), (const pg8::bf16_t*)(ws + WS_WIN), M, NIN, DM}; pg8::StaticOrder S; S.init(M, NIN, G, bid);
        pg8::EpiStoreBf16 E{(pg8::bf16_t*)(ws + WS_PROJ), NIN};
        pg8::gemm_phase<pg8::EpiStoreBf16, pg8::StaticOrder, true, true>(lds, g, S, E);
        __syncthreads();
    }
    SEAM(1);
    if (IN(2)) p2_qkprep(args, gw, NGW, lane);
    SEAM(2);
    if (IN(3)) {
        const att::bf16* proj = (const att::bf16*)(ws + WS_PROJ);
        for (int u = bid; u < 512; u += G) { const int h = u >> 6, qb = u & 63, kvh = h >> 2;
            att::attn_dense_body<att::bf16>(proj + (size_t)qb * 256 * NIN + C_Q + h * 128, proj + C_K + kvh * 128, proj + C_V + kvh * 128,
                                            (float*)(ws + WS_O) + (size_t)qb * 256 * AW + h * 128, M, (char*)lds_raw, args.in[I_QNW], args.in[I_KNW], (const float*)(ws + WS_TAB), qb * 256);
            __syncthreads(); }
        lru_phase(args, lds, bid, G, 1);
    }
    SEAM(3);
    if (IN(4)) carry_phase(args, gw, NGW, lane);
    SEAM(4);
    if (IN(5)) p4_mix(args, gw, NGW, lane);
    SEAM(5);
    if (IN(6)) {
        pg8::Gemm g{(const pg8::bf16_t*)(ws + WS_XN), (const pg8::bf16_t*)(ws + WS_WOUT), M, DM, MIXW}; pg8::StaticOrder S; S.init(M, DM, G, bid);
        pg8::EpiResidual E{args.in[I_X], args.out, DM};
        pg8::gemm_phase<pg8::EpiResidual, pg8::StaticOrder, true, true>(lds, g, S, E);
    }
#undef IN
#undef SEAM
}

#ifndef N_LAUNCHES
#define N_LAUNCHES 1
#endif
extern "C" void kernel_launch(void* const* d_in, const int* in_sizes, int n_in, void* d_out, int out_size, void* d_ws, size_t ws_size, hipStream_t stream) {
    static int grid = 0;
    if (grid == 0) {
        if (n_in != 15 || in_sizes[0] != M * DM || out_size != M * DM || ws_size < WS_END) { fprintf(stderr, "kernel_launch: shape/workspace mismatch (n_in %d, ws %zu)\n", n_in, ws_size); grid = -1; return; }
        int dev = 0, cus = 0, per_cu = 0;
        (void)hipGetDevice(&dev); (void)hipDeviceGetAttribute(&cus, hipDeviceAttributeMultiprocessorCount, dev);
        if (hipFuncSetAttribute((const void*)hybrid_fwd, hipFuncAttributeMaxDynamicSharedMemorySize, LDS_BYTES) != hipSuccess) { fprintf(stderr, "kernel_launch: hipFuncSetAttribute failed\n"); grid = -1; return; }
        if (hipOccupancyMaxActiveBlocksPerMultiprocessor(&per_cu, (const void*)hybrid_fwd, NTHREADS, LDS_BYTES) != hipSuccess || per_cu < 1) { fprintf(stderr, "kernel_launch: occupancy query gave %d\n", per_cu); per_cu = 1; }
        (void)hipGetLastError();
        grid = cus * 1;
    }
    if (grid < 0) return;
    Args a{};
    for (int i = 0; i < 15; ++i) a.in[i] = (const float*)d_in[i];
    a.out = (float*)d_out; a.ws = (unsigned char*)d_ws;
    if (hipMemsetAsync(d_ws, 0, 16384, stream) != hipSuccess) { fprintf(stderr, "kernel_launch: hipMemsetAsync failed\n"); return; }
    if (N_LAUNCHES == 1) {
        a.ph_lo = 0; a.ph_hi = 7;
        void* kargs[] = {&a};
        hipError_t e = hipLaunchCooperativeKernel((const void*)hybrid_fwd, dim3(grid), dim3(NTHREADS), kargs, LDS_BYTES, stream);
        if (e != hipSuccess) fprintf(stderr, "cooperative launch failed: %s (grid %d)\n", hipGetErrorString(e), grid);
    } else {
        for (int p = 0; p < 7; ++p) { a.ph_lo = p; a.ph_hi = p + 1; hipLaunchKernelGGL(hybrid_fwd, dim3(grid), dim3(NTHREADS), LDS_BYTES, stream, a); }
    }
}
```
